# Optimizing an MI355X kernel written in HIP

```python
import jax, jax.numpy as jnp
from jax import lax
import numpy as np

D_MODEL = 1024
BATCH = 16
SEQ = 2048
DEPTH = 1

CHUNK = 64
Q_BLOCK = 128
N_MEM = 256
RMS_EPS = 1e-6
FFN_HIDDEN = 2816
MLA_HEADS = 8
Q_LORA = 384
KV_LORA = 256
NOPE_DIM = 128
ROPE_DIM = 64
V_DIM = 128
ROPE_THETA = 10000.0
RNN_WIDTH = 1024
RNN_BLOCKS = 8
RNN_BLOCK_DIM = RNN_WIDTH // RNN_BLOCKS
CONV_WIDTH = 4
LRU_C = 8.0
MEM_HEADS = 4
MEM_HEAD_DIM = 256
MEM_WIDTH = MEM_HEADS * MEM_HEAD_DIM
N_BRANCH = 3
BRANCH_WIDTH = MLA_HEADS * V_DIM
IN_SPLITS = (Q_LORA, KV_LORA, ROPE_DIM, RNN_WIDTH, RNN_WIDTH, MEM_WIDTH, N_BRANCH * D_MODEL)
IN_WIDTH = sum(IN_SPLITS)
SPLIT_POINTS = [int(p) for p in np.cumsum(IN_SPLITS)[:-1]]

kernel_name = 'hybrid_mla_rglru_memxattn_macaron'


def rms_norm(x, g):
    xf = x.astype(jnp.float32)
    y = xf * lax.rsqrt(jnp.mean(xf * xf, axis=-1, keepdims=True) + RMS_EPS)
    return (y * g.astype(jnp.float32)).astype(x.dtype)


def swiglu_half_step(x, g, w_in, w_down):
    h = rms_norm(x, g)
    gate, up = jnp.split(h @ w_in, 2, axis=-1)
    return x + 0.5 * ((jax.nn.silu(gate) * up) @ w_down)


def rotary_tables(seq_len, dtype):
    pos = jnp.arange(seq_len, dtype=jnp.float32)
    inv_freq = 1.0 / (ROPE_THETA ** (jnp.arange(0, ROPE_DIM, 2, dtype=jnp.float32) / ROPE_DIM))
    ang = pos[:, None] * inv_freq[None, :]
    return jnp.cos(ang).astype(dtype), jnp.sin(ang).astype(dtype)


def rotary(x, cos, sin):
    x1, x2 = jnp.split(x, 2, axis=-1)
    return jnp.concatenate([x1 * cos - x2 * sin, x2 * cos + x1 * sin], axis=-1)


def block_causal_attention(q, k, v):
    seq = q.shape[1]
    scale = q.shape[-1] ** -0.5
    outs = []
    for blk in range(seq // Q_BLOCK):
        q_lo, q_hi = blk * Q_BLOCK, (blk + 1) * Q_BLOCK
        qb = q[:, q_lo:q_hi]
        kb = k[:, :q_hi]
        vb = v[:, :q_hi]
        s = jnp.einsum('bqhd,bkhd->bhqk', qb, kb).astype(jnp.float32) * scale
        q_chunk = jnp.arange(q_lo, q_hi) // CHUNK
        k_chunk = jnp.arange(q_hi) // CHUNK
        s = jnp.where(k_chunk[None, :] <= q_chunk[:, None], s, -jnp.inf)
        p = jax.nn.softmax(s, axis=-1).astype(vb.dtype)
        outs.append(jnp.einsum('bhqk,bkhd->bqhd', p, vb))
    return jnp.concatenate(outs, axis=1)


def mla_branch(z_cq, z_ckv, z_kr, q_norm, w_uq, kv_norm, w_ukv):
    bsz, seq = z_cq.shape[:2]
    cos, sin = rotary_tables(seq, z_cq.dtype)
    q = (rms_norm(z_cq, q_norm) @ w_uq).reshape(bsz, seq, MLA_HEADS, NOPE_DIM + ROPE_DIM)
    q_nope, q_rope = jnp.split(q, [NOPE_DIM], axis=-1)
    q = jnp.concatenate([q_nope, rotary(q_rope, cos[:, None, :], sin[:, None, :])], axis=-1)
    kv = (rms_norm(z_ckv, kv_norm) @ w_ukv).reshape(bsz, seq, MLA_HEADS, NOPE_DIM + V_DIM)
    k_nope, v = jnp.split(kv, [NOPE_DIM], axis=-1)
    k_rope = rotary(z_kr, cos, sin)
    k_rope = jnp.broadcast_to(k_rope[:, :, None, :], (bsz, seq, MLA_HEADS, ROPE_DIM))
    k = jnp.concatenate([k_nope, k_rope], axis=-1)
    o = block_causal_attention(q, k, v)
    return o.reshape(bsz, seq, MLA_HEADS * V_DIM)


def _linear_scan_combine(left, right):
    a_l, b_l = left
    a_r, b_r = right
    return a_l * a_r, a_r * b_l + b_r


def rglru_branch(z_x, z_g, conv_w, conv_b, w_rg_a, b_rg_a, w_rg_i, b_rg_i, lru_lambda):
    bsz, seq = z_x.shape[:2]
    xc = lax.conv_general_dilated(
        z_x, conv_w, window_strides=(1,), padding=[(CONV_WIDTH - 1, 0)],
        dimension_numbers=('NWC', 'WIO', 'NWC'), feature_group_count=RNN_WIDTH) + conv_b
    xr = xc.reshape(bsz, seq, RNN_BLOCKS, RNN_BLOCK_DIM)
    r = jax.nn.sigmoid(jnp.einsum('bsnd,nde->bsne', xr, w_rg_a) + b_rg_a).reshape(bsz, seq, RNN_WIDTH)
    i = jax.nn.sigmoid(jnp.einsum('bsnd,nde->bsne', xr, w_rg_i) + b_rg_i).reshape(bsz, seq, RNN_WIDTH)
    log_a = -LRU_C * r.astype(jnp.float32) * jax.nn.softplus(-lru_lambda.astype(jnp.float32))
    a = jnp.exp(log_a)
    u = jnp.sqrt(-jnp.expm1(2.0 * log_a)) * (i * xc).astype(jnp.float32)
    _, h = lax.associative_scan(_linear_scan_combine, (a, u), axis=1)
    return h.astype(z_x.dtype) * jax.nn.gelu(z_g)


def memory_branch(z_mq, mem, mem_norm, w_mem_kv):
    bsz, seq = z_mq.shape[:2]
    q = z_mq.reshape(bsz, seq, MEM_HEADS, MEM_HEAD_DIM)
    k, v = jnp.split(rms_norm(mem, mem_norm) @ w_mem_kv, 2, axis=-1)
    k = k.reshape(bsz, -1, MEM_HEADS, MEM_HEAD_DIM)
    v = v.reshape(bsz, -1, MEM_HEADS, MEM_HEAD_DIM)
    s = jnp.einsum('bshd,bmhd->bhsm', q, k).astype(jnp.float32) * (MEM_HEAD_DIM ** -0.5)
    p = jax.nn.softmax(s, axis=-1).astype(v.dtype)
    return jnp.einsum('bhsm,bmhd->bshd', p, v).reshape(bsz, seq, MEM_WIDTH)


def setup_inputs(seed: int = 0) -> dict:
    key = jax.random.key(seed)
    ks = jax.random.split(key, 32)
    L = DEPTH

    def dense(k, shape, fan_in):
        return jax.random.normal(k, shape, jnp.float32) * fan_in ** -0.5

    def gain(k, shape):
        return 1.0 + 0.02 * jax.random.normal(k, shape, jnp.float32)

    def small(k, shape):
        return 0.01 * jax.random.normal(k, shape, jnp.float32)

    a_c = jax.random.uniform(ks[18], (L, RNN_WIDTH), jnp.float32, 0.9, 0.999)
    base = a_c ** (1.0 / LRU_C)
    lru_lambda = jnp.log(base) - jnp.log1p(-base)
    return {
        'x': jax.random.normal(ks[0], (BATCH, SEQ, D_MODEL), jnp.float32),
        'mem': jax.random.normal(ks[1], (BATCH, N_MEM, D_MODEL), jnp.float32),
        'ffn1_norm': gain(ks[2], (L, D_MODEL)),
        'ffn1_w_in': dense(ks[3], (L, D_MODEL, 2 * FFN_HIDDEN), D_MODEL),
        'ffn1_w_down': dense(ks[4], (L, FFN_HIDDEN, D_MODEL), FFN_HIDDEN),
        'mix_norm': gain(ks[5], (L, D_MODEL)),
        'w_in': dense(ks[6], (L, D_MODEL, IN_WIDTH), D_MODEL),
        'b_gate': small(ks[7], (L, N_BRANCH, D_MODEL)),
        'q_norm': gain(ks[8], (L, Q_LORA)),
        'w_uq': dense(ks[9], (L, Q_LORA, MLA_HEADS * (NOPE_DIM + ROPE_DIM)), Q_LORA),
        'kv_norm': gain(ks[10], (L, KV_LORA)),
        'w_ukv': dense(ks[11], (L, KV_LORA, MLA_HEADS * (NOPE_DIM + V_DIM)), KV_LORA),
        'conv_w': dense(ks[12], (L, CONV_WIDTH, 1, RNN_WIDTH), CONV_WIDTH),
        'conv_b': small(ks[13], (L, RNN_WIDTH)),
        'w_rg_a': dense(ks[14], (L, RNN_BLOCKS, RNN_BLOCK_DIM, RNN_BLOCK_DIM), RNN_BLOCK_DIM),
        'b_rg_a': small(ks[15], (L, RNN_BLOCKS, RNN_BLOCK_DIM)),
        'w_rg_i': dense(ks[16], (L, RNN_BLOCKS, RNN_BLOCK_DIM, RNN_BLOCK_DIM), RNN_BLOCK_DIM),
        'b_rg_i': small(ks[17], (L, RNN_BLOCKS, RNN_BLOCK_DIM)),
        'lru_lambda': lru_lambda,
        'mem_norm': gain(ks[19], (L, D_MODEL)),
        'w_mem_kv': dense(ks[20], (L, D_MODEL, 2 * MEM_WIDTH), D_MODEL),
        'w_branch': dense(ks[21], (L, N_BRANCH, BRANCH_WIDTH, D_MODEL), BRANCH_WIDTH),
        'w_out': dense(ks[22], (L, D_MODEL, D_MODEL), D_MODEL),
        'ffn2_norm': gain(ks[23], (L, D_MODEL)),
        'ffn2_w_in': dense(ks[24], (L, D_MODEL, 2 * FFN_HIDDEN), D_MODEL),
        'ffn2_w_down': dense(ks[25], (L, FFN_HIDDEN, D_MODEL), FFN_HIDDEN),
        'final_norm': gain(ks[26], (D_MODEL,)),
    }


def reference(x, mem, ffn1_norm, ffn1_w_in, ffn1_w_down, mix_norm, w_in, b_gate,
              q_norm, w_uq, kv_norm, w_ukv, conv_w, conv_b, w_rg_a, b_rg_a,
              w_rg_i, b_rg_i, lru_lambda, mem_norm, w_mem_kv, w_branch, w_out,
              ffn2_norm, ffn2_w_in, ffn2_w_down, final_norm):
    bsz, seq = x.shape[:2]
    for l in range(DEPTH):
        x = swiglu_half_step(x, ffn1_norm[l], ffn1_w_in[l], ffn1_w_down[l])
        h = rms_norm(x, mix_norm[l])
        z = h @ w_in[l]
        z_cq, z_ckv, z_kr, z_x, z_g, z_mq, z_gate = jnp.split(z, SPLIT_POINTS, axis=-1)
        y_a = mla_branch(z_cq, z_ckv, z_kr, q_norm[l], w_uq[l], kv_norm[l], w_ukv[l])
        y_b = rglru_branch(z_x, z_g, conv_w[l], conv_b[l], w_rg_a[l], b_rg_a[l],
                           w_rg_i[l], b_rg_i[l], lru_lambda[l])
        y_c = memory_branch(z_mq, mem, mem_norm[l], w_mem_kv[l])
        branches = jnp.stack([y_a, y_b, y_c], axis=2)
        gates = jax.nn.sigmoid(z_gate.reshape(bsz, seq, N_BRANCH, D_MODEL) + b_gate[l])
        proj = jnp.einsum('bsnc,ncd->bsnd', branches, w_branch[l])
        merged = jnp.sum(gates * proj, axis=2)
        x = x + merged @ w_out[l]
        x = swiglu_half_step(x, ffn2_norm[l], ffn2_w_in[l], ffn2_w_down[l])
    return rms_norm(x, final_norm)
```

```cpp
#include <hip/hip_runtime.h>
#include <hip/hip_cooperative_groups.h>
#include <cstdio>
namespace cg = cooperative_groups;

#ifndef MK_ONE_LAUNCH
#define MK_ONE_LAUNCH 1
#endif

#define LAS __attribute__((address_space(3)))
typedef unsigned short bf16_t;
typedef short bf16x8 __attribute__((ext_vector_type(8)));
typedef short bf16x4 __attribute__((ext_vector_type(4)));
typedef float f32x4 __attribute__((ext_vector_type(4)));
typedef float f32x2 __attribute__((ext_vector_type(2)));
typedef unsigned u32x4 __attribute__((ext_vector_type(4)));
typedef unsigned u32x2 __attribute__((ext_vector_type(2)));

constexpr int D = 1024, T = 32768, SEQ = 2048, FF = 2816, NBATCH = 16;
constexpr int GB = 8, TG = GB * SEQ, NG = NBATCH / GB;
constexpr int NMEM = 256, TMEM = NBATCH * NMEM;
constexpr int INW = 6848;

constexpr size_t MiB = 1u << 20;
constexpr size_t O_W1IN = 0;
constexpr size_t O_W1DN = O_W1IN + (size_t)5632 * 1024 * 2;
constexpr size_t O_W2IN = O_W1DN + (size_t)1024 * 2816 * 2;
constexpr size_t O_W2DN = O_W2IN + (size_t)5632 * 1024 * 2;
constexpr size_t O_WINA = O_W2DN + (size_t)1024 * 2816 * 2;
constexpr size_t O_WGATE = O_WINA + (size_t)3840 * 1024 * 2;
constexpr size_t O_WUQ = O_WGATE + (size_t)3072 * 1024 * 2;
constexpr size_t O_WUK = O_WUQ + (size_t)1536 * 384 * 2;
constexpr size_t O_WUV = O_WUK + (size_t)1024 * 256 * 2;
constexpr size_t O_WMK = O_WUV + (size_t)1024 * 256 * 2;
constexpr size_t O_WMV = O_WMK + (size_t)1024 * 1024 * 2;
constexpr size_t O_WBR = O_WMV + (size_t)1024 * 1024 * 2;
constexpr size_t O_WOUT = O_WBR + (size_t)3 * 1024 * 1024 * 2;
constexpr size_t O_WRGA = O_WOUT + (size_t)1024 * 1024 * 2;
constexpr size_t O_WRGI = O_WRGA + (size_t)8 * 128 * 128 * 2;
constexpr size_t O_ROPE = O_WRGI + (size_t)8 * 128 * 128 * 2;
constexpr size_t O_MEMK = O_ROPE + (size_t)2048 * 32 * 8;
constexpr size_t O_MEMVT = O_MEMK + (size_t)TMEM * 1024 * 2;
constexpr size_t O_R = ((O_MEMVT + (size_t)TMEM * 1024 * 2 + MiB - 1) / MiB) * MiB;
constexpr size_t O_H = O_R;
constexpr size_t O_HID = O_H + 64 * MiB;
constexpr size_t O_MEMN = O_HID + 176 * MiB;
constexpr size_t O_ZX = O_H + 64 * MiB;
constexpr size_t O_ZG = O_ZX + 32 * MiB;
constexpr size_t O_ZMQ = O_ZG + 32 * MiB;
constexpr size_t O_ZL = O_ZMQ + 32 * MiB;
constexpr size_t O_CQN = O_ZL + 24 * MiB;
constexpr size_t O_CKVN = O_CQN + 12 * MiB;
constexpr size_t O_KROPE = O_CKVN + 8 * MiB;
constexpr size_t O_LAU = O_KROPE + 2 * MiB;
constexpr size_t O_SUMM = O_LAU + 64 * MiB;
constexpr size_t O_Q = O_SUMM + 1 * MiB;
constexpr size_t O_KNOPE = O_Q + 48 * MiB;
constexpr size_t O_VT = O_KNOPE + 32 * MiB;
constexpr size_t O_BAR = O_VT + 32 * MiB;
constexpr size_t O_END = O_BAR + 65536;
static_assert(O_END <= 512 * MiB, "workspace");
static_assert(O_MEMN + 8 * MiB <= 512 * MiB, "workspace");

constexpr int LDS_MAIN = 151552;
constexpr int LDS_BYTES = LDS_MAIN + 16;

__device__ __forceinline__ float bf2f(bf16_t b) { return __uint_as_float(((unsigned)b) << 16); }
__device__ __forceinline__ bf16_t f2bf(float f) { unsigned u = __float_as_uint(f); u += 0x7FFFu + ((u >> 16) & 1u); return (bf16_t)(u >> 16); }
typedef __bf16 bf16v2 __attribute__((ext_vector_type(2)));
__device__ __forceinline__ unsigned pk2(float lo, float hi) { const f32x2 v = {lo, hi}; const bf16v2 b = __builtin_convertvector(v, bf16v2); return __builtin_bit_cast(unsigned, b); }
__device__ __forceinline__ float lo_f(unsigned w) { return __uint_as_float(w << 16); }
__device__ __forceinline__ float hi_f(unsigned w) { return __uint_as_float(w & 0xffff0000u); }
__device__ __forceinline__ float sigmoidf_(float x) { return __builtin_amdgcn_rcpf(1.0f + __expf(-x)); }
__device__ __forceinline__ float gelu_tanh(float x) { const float t = 1.5957691216f * (x + 0.044715f * x * x * x); return x * __builtin_amdgcn_rcpf(1.0f + __expf(-t)); }
__device__ __forceinline__ float wave_sum(float v) { v += __shfl_xor(v, 32); v += __shfl_xor(v, 16); v += __shfl_xor(v, 8); v += __shfl_xor(v, 4); v += __shfl_xor(v, 2); v += __shfl_xor(v, 1); return v; }

__device__ __forceinline__ int opaque_tid() { int t = threadIdx.x; asm volatile("" : "+v"(t)); return t; }
struct Params { const float* in[27]; float* out; unsigned char* ws; int ph_lo, ph_hi; };

namespace pg8 {
constexpr int BM = 256, BK = 64, HALF = 128, HTB = HALF * BK * 2, NXCD = 8, WGM = 4;
__device__ __forceinline__ int lds_byte(int r, int c) { const int st = (r >> 4) * 2 + (c >> 5), rr = r & 15, cc = c & 31, ob = rr * 64 + cc * 2; return st * 1024 + (ob ^ (((ob >> 9) & 1) << 5)); }
__device__ __forceinline__ void stage_rc(int b, int& R, int& C) { const int st = b / 1024, sb = b % 1024, swz = sb ^ (((sb >> 9) & 1) << 5); R = (st >> 1) * 16 + swz / 64; C = (st & 1) * 32 + (swz % 64) / 2; }
__device__ __forceinline__ int perm32(int rho) { const int n = rho >> 4, i = rho & 15; return 8 * (i >> 2) + 4 * n + (i & 3); }

struct Unit { const char* A; const char* B; int pm, pn, aux; };

__device__ __forceinline__ void tile_of(int L, int nM, int nN, int& pm, int& pn) {
    const int nwg = nM * nN; int wgid = L;
    { const int q = nwg / NXCD, r = nwg % NXCD, xcd = wgid % NXCD, off = wgid / NXCD; wgid = (xcd < r ? xcd * (q + 1) : r * (q + 1) + (xcd - r) * q) + off; }
    const int nig = WGM * nN, gid = wgid / nig, fm = gid * WGM, gsz = (nM - fm) < WGM ? (nM - fm) : WGM;
    pm = fm + ((wgid % nig) % gsz); pn = (wgid % nig) / gsz;
}
struct Sched3 {
    const bf16_t *A0, *B0, *A1, *B1, *A2, *B2; int nM0, nN0, nM1, nN1, nM2, nN2; int G, c, K;
    __device__ __forceinline__ bool next(int i, Unit& u) const {
        int L = i * G + c; const size_t tstep = (size_t)BM * K * 2;
        const int n0 = nM0 * nN0, n1 = nM1 * nN1, n2 = nM2 * nN2;
        if (L < n0) { tile_of(L, nM0, nN0, u.pm, u.pn); u.A = (const char*)A0 + u.pm * tstep; u.B = (const char*)B0 + u.pn * tstep; u.aux = 0; return true; }
        L -= n0;
        if (L < n1) { tile_of(L, nM1, nN1, u.pm, u.pn); u.A = (const char*)A1 + u.pm * tstep; u.B = (const char*)B1 + u.pn * tstep; u.aux = 1; return true; }
        L -= n1;
        if (L < n2) { tile_of(L, nM2, nN2, u.pm, u.pn); u.A = (const char*)A2 + u.pm * tstep; u.B = (const char*)B2 + u.pn * tstep; u.aux = 2; return true; }
        return false;
    }
};
struct SchedMerge {
    const unsigned char* ws; size_t h2g_off; int G, c;
    __device__ __forceinline__ bool next(int i, Unit& u) const {
        const int tile = (i / 6) * G + c; if (tile >= (TG / 256) * 4) return false;
        const int sub = i % 6, b = sub >> 1, kind = sub & 1; const size_t tstep = (size_t)BM * 1024 * 2;
        u.pm = tile >> 2; u.pn = tile & 3; u.aux = sub;
        const size_t yoff = (size_t)(b == 0) * O_LAU + (size_t)(b == 1) * O_ZX + (size_t)(b == 2) * O_ZMQ;
        const size_t aoff = (size_t)(kind == 0) * h2g_off + (size_t)(kind != 0) * yoff;
        const size_t woff = (size_t)(kind == 0) * O_WGATE + (size_t)(kind != 0) * O_WBR;
        u.A = (const char*)ws + aoff + u.pm * tstep; u.B = (const char*)ws + woff + (size_t)(b * 4 + u.pn) * tstep; return true;
    }
};

template <class Epi, class Sched>
__device__ __forceinline__ void gemm_phase(LAS unsigned char* lds, const int K, const Sched& S, const Epi& E) {
    const int tid = opaque_tid(), wid = __builtin_amdgcn_readfirstlane(tid >> 6), lane = tid & 63, wr = wid >> 2, wc = wid & 3, fr = lane & 15, fq = lane >> 4;
    const int nt = K / BK;
    unsigned voffA[2], voffB[2];
#pragma unroll
    for (int i = 0; i < 2; ++i) { int R, C; stage_rc(tid * 16 + i * 8192, R, C); const int Rb = Epi::PERM ? ((R & ~31) + perm32(R & 31)) : R;
        voffA[i] = (unsigned)(R * K + C) * 2u; voffB[i] = (unsigned)(Rb * K + C) * 2u; }
    const size_t kstep = (size_t)(BK * 2);
    const size_t hstep = (size_t)HALF * K * 2;
    const unsigned ldsw = (unsigned)wid * 1024u;
    const int aoff = lds_byte(wr * 64 + fr, fq * 8), boff = lds_byte(wc * 32 + fr, fq * 8);
#define PG8_SA(b, h) (((b) * 2 + (h)) * HTB)
#define PG8_SB(b, h) ((4 + (b) * 2 + (h)) * HTB)
#define PG8_STAGE(bufoff, gbase, voff) do { _Pragma("unroll") for (int _i = 0; _i < 2; ++_i) \
        __builtin_amdgcn_global_load_lds((const unsigned*)((const char*)(gbase) + (voff)[_i]), (LAS unsigned*)(lds + (bufoff) + ldsw + _i * 8192), 16, 0, 0); } while (0)
#define PG8_LDA(dst, b, h) do { _Pragma("unroll") for (int m = 0; m < 4; ++m) _Pragma("unroll") for (int k = 0; k < 2; ++k) dst[m][k] = *(const LAS bf16x8*)(lds + PG8_SA(b, h) + aoff + m * 2048 + k * 1024); } while (0)
#define PG8_LDB(dst, b, h) do { _Pragma("unroll") for (int n = 0; n < 2; ++n) _Pragma("unroll") for (int k = 0; k < 2; ++k) dst[n][k] = *(const LAS bf16x8*)(lds + PG8_SB(b, h) + boff + n * 2048 + k * 1024); } while (0)
#define PG8_MMA(ai, bj, At, Bt) do { __builtin_amdgcn_s_setprio(1); _Pragma("unroll") for (int m = 0; m < 4; ++m) _Pragma("unroll") for (int n = 0; n < 2; ++n) _Pragma("unroll") for (int k = 0; k < 2; ++k) \
        acc[ai][bj][m][n] = __builtin_amdgcn_mfma_f32_16x16x32_bf16(Bt[n][k], At[m][k], acc[ai][bj][m][n], 0, 0, 0); __builtin_amdgcn_s_setprio(0); } while (0)
#define PG8_WAIT_V(n) asm volatile("s_waitcnt vmcnt(" #n ")" ::: "memory")
#define PG8_WAIT_L(n) asm volatile("s_waitcnt lgkmcnt(" #n ")" ::: "memory")
#define PG8_BAR __builtin_amdgcn_s_barrier()
#define PG8_SCHED __builtin_amdgcn_sched_barrier(0)
    Unit cur, nxt; int ui = 0;
    if (!S.next(0, cur)) return;
    f32x4 acc[2][2][4][2];
#pragma unroll
    for (int a = 0; a < 2; ++a)
#pragma unroll
        for (int b = 0; b < 2; ++b)
#pragma unroll
            for (int m = 0; m < 4; ++m)
#pragma unroll
                for (int n = 0; n < 2; ++n) acc[a][b][m][n] = (f32x4){0.f, 0.f, 0.f, 0.f};
    bf16x8 At[4][2], B0[2][2], B1[2][2];
    const char* cA = cur.A; const char* cB = cur.B;
    PG8_STAGE(PG8_SB(0, 0), cB, voffB); PG8_STAGE(PG8_SA(0, 0), cA, voffA); PG8_STAGE(PG8_SB(0, 1), cB + hstep, voffB); PG8_STAGE(PG8_SA(0, 1), cA + hstep, voffA);
    if (wr == 1) PG8_BAR;
    PG8_WAIT_V(4); PG8_BAR;
    PG8_STAGE(PG8_SB(1, 0), cB + kstep, voffB); PG8_STAGE(PG8_SA(1, 0), cA + kstep, voffA); PG8_STAGE(PG8_SB(1, 1), cB + hstep + kstep, voffB);
    PG8_WAIT_V(6); PG8_BAR;
    for (;;) {
        const bool has_next = S.next(ui + 1, nxt);
        const char* nA = has_next ? nxt.A : cA; const char* nB = has_next ? nxt.B : cB;
        for (int t = 0; t < nt; t += 2) {
            const bool last = (t == nt - 2);
            const char* a1 = cA + (size_t)(t + 1) * kstep;
            const char* a2 = last ? nA : cA + (size_t)(t + 2) * kstep; const char* b2 = last ? nB : cB + (size_t)(t + 2) * kstep;
            const char* a3 = a2 + kstep; const char* b3 = b2 + kstep;
            PG8_LDB(B0, 0, 0); PG8_SCHED; PG8_LDA(At, 0, 0); PG8_STAGE(PG8_SA(1, 1), a1 + hstep, voffA);
            PG8_WAIT_L(8); PG8_BAR; PG8_WAIT_L(0); PG8_MMA(0, 0, At, B0); PG8_BAR; PG8_SCHED;
            PG8_LDB(B1, 0, 1); PG8_STAGE(PG8_SB(0, 0), b2, voffB);
            PG8_BAR; PG8_WAIT_L(0); PG8_MMA(0, 1, At, B1); PG8_BAR;
            PG8_LDA(At, 0, 1); PG8_STAGE(PG8_SA(0, 0), a2, voffA);
            PG8_BAR; PG8_WAIT_L(0); PG8_MMA(1, 0, At, B0); PG8_BAR; PG8_SCHED;
            PG8_STAGE(PG8_SB(0, 1), b2 + hstep, voffB);
            PG8_WAIT_V(6); PG8_BAR; PG8_MMA(1, 1, At, B1); PG8_BAR;
            PG8_LDB(B0, 1, 0); PG8_SCHED; PG8_LDA(At, 1, 0); PG8_STAGE(PG8_SA(0, 1), a2 + hstep, voffA);
            PG8_WAIT_L(8); PG8_BAR; PG8_WAIT_L(0); PG8_MMA(0, 0, At, B0); PG8_BAR; PG8_SCHED;
            PG8_LDB(B1, 1, 1); PG8_STAGE(PG8_SB(1, 0), b3, voffB);
            PG8_BAR; PG8_WAIT_L(0); PG8_MMA(0, 1, At, B1); PG8_BAR;
            PG8_LDA(At, 1, 1); PG8_STAGE(PG8_SA(1, 0), a3, voffA);
            PG8_BAR; PG8_WAIT_L(0); PG8_MMA(1, 0, At, B0); PG8_BAR; PG8_SCHED;
            PG8_STAGE(PG8_SB(1, 1), b3 + hstep, voffB);
            PG8_WAIT_V(6); PG8_BAR; PG8_MMA(1, 1, At, B1); PG8_BAR;
        }
        E(acc, cur, wr, wc, fr, fq);
        if (!has_next) break;
#pragma unroll
        for (int a = 0; a < 2; ++a)
#pragma unroll
            for (int b = 0; b < 2; ++b)
#pragma unroll
                for (int m = 0; m < 4; ++m)
#pragma unroll
                    for (int n = 0; n < 2; ++n) acc[a][b][m][n] = (f32x4){0.f, 0.f, 0.f, 0.f};
        cur = nxt; cA = nA; cB = nB; ++ui;
    }
    PG8_WAIT_V(0);
    if (wr == 0) PG8_BAR;
    PG8_BAR;
#undef PG8_SA
#undef PG8_SB
#undef PG8_STAGE
#undef PG8_LDA
#undef PG8_LDB
#undef PG8_MMA
#undef PG8_WAIT_V
#undef PG8_WAIT_L
#undef PG8_BAR
#undef PG8_SCHED
}

typedef f32x4 Acc[2][2][4][2];
template <int ACT>
__device__ __forceinline__ void store_bf16_tile(const Acc& acc, bf16_t* O, int ld, int rowbase, int colbase, int wr, int wc, int fr, int fq) {
    const int row0 = rowbase + wr * 64 + fr, col0 = colbase + wc * 32 + 8 * fq;
#pragma unroll
    for (int ai = 0; ai < 2; ++ai)
#pragma unroll
        for (int m = 0; m < 4; ++m) { bf16_t* rowp = O + (size_t)(row0 + ai * HALF + m * 16) * ld + col0;
#pragma unroll
            for (int bj = 0; bj < 2; ++bj) { f32x4 v0 = acc[ai][bj][m][0], v1 = acc[ai][bj][m][1];
                if (ACT == 1) {
#pragma unroll
                    for (int j = 0; j < 4; ++j) { v0[j] = gelu_tanh(v0[j]); v1[j] = gelu_tanh(v1[j]); } }
                u32x4 w; w.x = pk2(v0[0], v0[1]); w.y = pk2(v0[2], v0[3]); w.z = pk2(v1[0], v1[1]); w.w = pk2(v1[2], v1[3]);
                *(u32x4*)(rowp + bj * HALF) = w; } }
}
struct EpiFfnIn {
    static constexpr bool PERM = true;
    bf16_t* hid; bf16_t* memK; bf16_t* memVt;
    __device__ __forceinline__ void operator()(const Acc& acc, const Unit& u, int wr, int wc, int fr, int fq) const {
        if (u.aux == 0) {
            const int row0 = u.pm * BM + wr * 64 + fr, col0 = u.pn * HALF + wc * 32 + 8 * fq;
#pragma unroll
            for (int ai = 0; ai < 2; ++ai)
#pragma unroll
                for (int m = 0; m < 4; ++m) {
                    float o[8];
#pragma unroll
                    for (int n = 0; n < 2; ++n)
#pragma unroll
                        for (int j = 0; j < 4; ++j) { const float g = acc[ai][0][m][n][j], up = acc[ai][1][m][n][j]; o[n * 4 + j] = g * __builtin_amdgcn_rcpf(1.0f + __expf(-g)) * up; }
                    u32x4 w; w.x = pk2(o[0], o[1]); w.y = pk2(o[2], o[3]); w.z = pk2(o[4], o[5]); w.w = pk2(o[6], o[7]);
                    *(u32x4*)(hid + (size_t)(row0 + ai * HALF + m * 16) * FF + col0) = w; }
        } else if (u.aux == 1) store_bf16_tile<0>(acc, memK, 1024, u.pm * BM, u.pn * BM, wr, wc, fr, fq);
        else store_bf16_tile<0>(acc, memVt, TMEM, u.pm * BM, u.pn * BM, wr, wc, fr, fq);
    }
};
struct EpiResid {
    static constexpr bool PERM = false;
    const float* res; float* out; float scale;
    __device__ __forceinline__ void operator()(const Acc& acc, const Unit& u, int wr, int wc, int fr, int fq) const {
        const int row0 = u.pm * BM + wr * 64 + fr, col0 = u.pn * BM + wc * 32 + 4 * fq;
#pragma unroll
        for (int ai = 0; ai < 2; ++ai) {
            f32x4 r[4][2][2];
#pragma unroll
            for (int m = 0; m < 4; ++m) { const size_t off = (size_t)(row0 + ai * HALF + m * 16) * D + col0;
#pragma unroll
                for (int bj = 0; bj < 2; ++bj)
#pragma unroll
                    for (int n = 0; n < 2; ++n) r[m][bj][n] = *(const f32x4*)(res + off + bj * HALF + n * 16); }
            asm volatile("" ::: "memory");
#pragma unroll
            for (int m = 0; m < 4; ++m) { const size_t off = (size_t)(row0 + ai * HALF + m * 16) * D + col0;
#pragma unroll
                for (int bj = 0; bj < 2; ++bj)
#pragma unroll
                    for (int n = 0; n < 2; ++n) *(f32x4*)(out + off + bj * HALF + n * 16) = r[m][bj][n] + acc[ai][bj][m][n] * scale; }
            asm volatile("" ::: "memory");
        }
    }
};
struct EpiInProj {
    static constexpr bool PERM = true;
    bf16_t *zx, *zg, *zmq, *zl;
    __device__ __forceinline__ void operator()(const Acc& acc, const Unit& u, int wr, int wc, int fr, int fq) const {
        const int pn = u.pn;
        if (pn < 4) store_bf16_tile<0>(acc, zx, 1024, u.pm * BM, pn * BM, wr, wc, fr, fq);
        else if (pn < 8) store_bf16_tile<1>(acc, zg, 1024, u.pm * BM, (pn - 4) * BM, wr, wc, fr, fq);
        else if (pn < 12) store_bf16_tile<0>(acc, zmq, 1024, u.pm * BM, (pn - 8) * BM, wr, wc, fr, fq);
        else store_bf16_tile<0>(acc, zl, 768, u.pm * BM, (pn - 12) * BM, wr, wc, fr, fq);
    }
};
struct EpiPlain1 {
    static constexpr bool PERM = true;
    bf16_t* O; int ld;
    __device__ __forceinline__ void operator()(const Acc& acc, const Unit& u, int wr, int wc, int fr, int fq) const {
        store_bf16_tile<0>(acc, O, ld, u.pm * BM, u.pn * BM, wr, wc, fr, fq);
    }
};
struct EpiMerge {
    static constexpr bool PERM = true;
    bf16_t* gtmp; float* mrg; bf16_t* merged; const float* bgate;
    __device__ __forceinline__ void operator()(const Acc& acc, const Unit& u, int wr, int wc, int fr, int fq) const {
        const int b = u.aux >> 1, kind = u.aux & 1;
        const int row0 = u.pm * BM + wr * 64 + fr, col0 = u.pn * BM + wc * 32 + 8 * fq;
        if (kind == 0) {
#pragma unroll
            for (int bj = 0; bj < 2; ++bj) { const f32x4 b0 = *(const f32x4*)(bgate + b * D + col0 + bj * HALF), b1 = *(const f32x4*)(bgate + b * D + col0 + bj * HALF + 4);
#pragma unroll
                for (int ai = 0; ai < 2; ++ai)
#pragma unroll
                    for (int m = 0; m < 4; ++m) { f32x4 v0 = acc[ai][bj][m][0] + b0, v1 = acc[ai][bj][m][1] + b1;
#pragma unroll
                        for (int j = 0; j < 4; ++j) { v0[j] = sigmoidf_(v0[j]); v1[j] = sigmoidf_(v1[j]); }
                        u32x4 w; w.x = pk2(v0[0], v0[1]); w.y = pk2(v0[2], v0[3]); w.z = pk2(v1[0], v1[1]); w.w = pk2(v1[2], v1[3]);
                        *(u32x4*)(gtmp + (size_t)(row0 + ai * HALF + m * 16) * D + col0 + bj * HALF) = w; } }
        } else {
            bf16_t* mrgb = (bf16_t*)mrg;
#pragma unroll
            for (int ai = 0; ai < 2; ++ai) {
                u32x4 gq[4][2], mq[4][2];
#pragma unroll
                for (int m = 0; m < 4; ++m)
#pragma unroll
                    for (int bj = 0; bj < 2; ++bj) { const size_t off = (size_t)(row0 + ai * HALF + m * 16) * D + col0 + bj * HALF;
                        gq[m][bj] = *(const u32x4*)(gtmp + off);
                        mq[m][bj] = (u32x4){0u, 0u, 0u, 0u}; if (b > 0) mq[m][bj] = *(const u32x4*)(mrgb + off); }
                asm volatile("" ::: "memory");
#pragma unroll
                for (int m = 0; m < 4; ++m)
#pragma unroll
                    for (int bj = 0; bj < 2; ++bj) { const size_t off = (size_t)(row0 + ai * HALF + m * 16) * D + col0 + bj * HALF;
                        const u32x4 g = gq[m][bj], q = mq[m][bj];
                        f32x4 v0, v1; v0[0] = lo_f(g.x); v0[1] = hi_f(g.x); v0[2] = lo_f(g.y); v0[3] = hi_f(g.y); v1[0] = lo_f(g.z); v1[1] = hi_f(g.z); v1[2] = lo_f(g.w); v1[3] = hi_f(g.w);
                        f32x4 p0, p1; p0[0] = lo_f(q.x); p0[1] = hi_f(q.x); p0[2] = lo_f(q.y); p0[3] = hi_f(q.y); p1[0] = lo_f(q.z); p1[1] = hi_f(q.z); p1[2] = lo_f(q.w); p1[3] = hi_f(q.w);
                        v0 = v0 * acc[ai][bj][m][0] + p0; v1 = v1 * acc[ai][bj][m][1] + p1;
                        u32x4 w; w.x = pk2(v0[0], v0[1]); w.y = pk2(v0[2], v0[3]); w.z = pk2(v1[0], v1[1]); w.w = pk2(v1[2], v1[3]);
                        if (b < 2) *(u32x4*)(mrgb + off) = w; else *(u32x4*)(merged + off) = w; }
                asm volatile("" ::: "memory");
            }
        }
    }
};
}

__device__ __forceinline__ int wt_srccol(int map, int n0) {
    switch (map) {
        case 1: { const int pn = n0 >> 8, bj = (n0 >> 7) & 1, i = n0 & 127; return bj * FF + pn * 128 + i; }
        case 2: return n0 < 3072 ? 704 + n0 : (n0 < 3776 ? n0 - 3072 : -1);
        case 3: return 3776 + n0;
        case 4: return (n0 >> 7) * 256 + (n0 & 127);
        case 5: return (n0 >> 7) * 256 + 128 + (n0 & 127);
        case 6: return 1024 + n0;
        default: return n0;
    }
}
template <bool WEIGHTED>
__device__ __forceinline__ void wt_job(const float* __restrict__ src, int src_ld, bf16_t* __restrict__ dst, int K, int Np, int map, LAS unsigned char* lds, int G, int c) {
    const int tid = opaque_tid(), wid = tid >> 6, lane = tid & 63, kg = lane >> 3, ng = lane & 7; const int tk_n = K / 64, tn_n = Np / 32;
    const int hw = (G >> 1) * 8;
    const bool light = WEIGHTED && c < (G >> 1);
    const int w0 = WEIGHTED ? (light ? c * 8 + wid : (c - (G >> 1)) * 8 + wid) : c * 8 + wid;
    const int ustep = WEIGHTED ? hw : G * 8;
    for (int u = w0; ; u += 2 * ustep) {
        int tt[2]; bool ok[2]; f32x4 v[2][8]; int n0s[2], k0s[2];
#pragma unroll
        for (int h = 0; h < 2; ++h) { const int uu = u + h * ustep;
            tt[h] = !WEIGHTED ? uu : (light ? (uu >> 1) * 10 + 8 + (uu & 1) : (uu >> 3) * 10 + (uu & 7)); ok[h] = tt[h] < tk_n * tn_n;
            const int tn = tt[h] / tk_n, tk = tt[h] % tk_n; n0s[h] = tn * 32; k0s[h] = tk * 64; const int sc = ok[h] ? wt_srccol(map, n0s[h]) : -1;
#pragma unroll
            for (int j = 0; j < 8; ++j) { v[h][j] = (f32x4){0.f, 0.f, 0.f, 0.f}; if (sc >= 0) v[h][j] = *(const f32x4*)(src + (size_t)(k0s[h] + kg * 8 + j) * src_ld + sc + ng * 4); } }
        if (!ok[0]) break;
#pragma unroll
        for (int h = 0; h < 2; ++h) if (ok[h]) {
#pragma unroll
            for (int i = 0; i < 4; ++i) { u32x4 w; w.x = pk2(v[h][0][i], v[h][1][i]); w.y = pk2(v[h][2][i], v[h][3][i]); w.z = pk2(v[h][4][i], v[h][5][i]); w.w = pk2(v[h][6][i], v[h][7][i]);
                *(u32x4*)(dst + (size_t)(n0s[h] + ng * 4 + i) * K + k0s[h] + kg * 8) = w; } }
        if (!ok[1]) break;
    }
}
constexpr int NR = 4;
__device__ __forceinline__ void rmsnorm_rows_bf16(const float* __restrict__ X, const float* __restrict__ g, bf16_t* __restrict__ out, int nrows, int G, int c) {
    const int tid_ = opaque_tid(); const int wid = tid_ >> 6, lane = tid_ & 63;
    f32x4 gv[4];
#pragma unroll
    for (int i = 0; i < 4; ++i) gv[i] = ((const f32x4*)g)[lane + 64 * i];
    for (int r = (c * 8 + wid) * NR; r < nrows; r += G * 8 * NR) {
        f32x4 v[NR][4]; float ss[NR]; _Pragma("unroll") for (int q = 0; q < NR; ++q) ss[q] = 0.f;
#pragma unroll
        for (int q = 0; q < NR; ++q)
#pragma unroll
            for (int i = 0; i < 4; ++i) v[q][i] = ((const f32x4*)(X + (size_t)(r + q) * D))[lane + 64 * i];
#pragma unroll
        for (int q = 0; q < NR; ++q) {
#pragma unroll
            for (int i = 0; i < 4; ++i) ss[q] += v[q][i][0] * v[q][i][0] + v[q][i][1] * v[q][i][1] + v[q][i][2] * v[q][i][2] + v[q][i][3] * v[q][i][3];
            ss[q] = wave_sum(ss[q]); const float rstd = rsqrtf(ss[q] * (1.0f / D) + 1e-6f);
#pragma unroll
            for (int i = 0; i < 4; ++i) { u32x2 w; w.x = pk2(v[q][i][0] * rstd * gv[i][0], v[q][i][1] * rstd * gv[i][1]); w.y = pk2(v[q][i][2] * rstd * gv[i][2], v[q][i][3] * rstd * gv[i][3]);
                *(u32x2*)(out + (size_t)(r + q) * D + (lane + 64 * i) * 4) = w; }
        }
    }
}
__device__ __forceinline__ void rmsnorm_rows_f32_inplace(float* X, const float* __restrict__ g, int nrows, int G, int c) {
    const int tid_ = opaque_tid(); const int wid = tid_ >> 6, lane = tid_ & 63;
    f32x4 gv[4];
#pragma unroll
    for (int i = 0; i < 4; ++i) gv[i] = ((const f32x4*)g)[lane + 64 * i];
    for (int r = (c * 8 + wid) * NR; r < nrows; r += G * 8 * NR) {
        f32x4 v[NR][4]; float ss[NR]; _Pragma("unroll") for (int q = 0; q < NR; ++q) ss[q] = 0.f;
#pragma unroll
        for (int q = 0; q < NR; ++q)
#pragma unroll
            for (int i = 0; i < 4; ++i) v[q][i] = ((const f32x4*)(X + (size_t)(r + q) * D))[lane + 64 * i];
        asm volatile("" ::: "memory");
#pragma unroll
        for (int q = 0; q < NR; ++q) {
#pragma unroll
            for (int i = 0; i < 4; ++i) ss[q] += v[q][i][0] * v[q][i][0] + v[q][i][1] * v[q][i][1] + v[q][i][2] * v[q][i][2] + v[q][i][3] * v[q][i][3];
            ss[q] = wave_sum(ss[q]); const float rstd = rsqrtf(ss[q] * (1.0f / D) + 1e-6f);
#pragma unroll
            for (int i = 0; i < 4; ++i) ((f32x4*)(X + (size_t)(r + q) * D))[lane + 64 * i] = v[q][i] * rstd * gv[i];
        }
    }
}
__device__ __forceinline__ void latent_rows(const bf16_t* __restrict__ zl, const float* __restrict__ qn, const float* __restrict__ kvn, const f32x2* __restrict__ rope, bf16_t* __restrict__ cqn, bf16_t* __restrict__ ckvn, bf16_t* __restrict__ krope, int G, int c) {
    const int tid_ = opaque_tid(); const int wid = tid_ >> 6, lane = tid_ & 63;
    for (int r = c * 8 + wid; r < TG; r += G * 8) {
        const bf16_t* zp = zl + (size_t)r * 768;
        float a[6]; float ss = 0.f;
        unsigned wq[3];
#pragma unroll
        for (int i = 0; i < 3; ++i) wq[i] = *(const unsigned*)(zp + lane * 2 + 128 * i);
        const u32x2 w2 = *(const u32x2*)(zp + 384 + lane * 4); const float v = bf2f(zp[640 + lane]);
        const f32x2 cs = rope[(r & (SEQ - 1)) * 32 + (lane & 31)];
#pragma unroll
        for (int i = 0; i < 3; ++i) { const unsigned w = wq[i]; a[2 * i] = lo_f(w); a[2 * i + 1] = hi_f(w); ss += a[2 * i] * a[2 * i] + a[2 * i + 1] * a[2 * i + 1]; }
        ss = wave_sum(ss); const float rq = rsqrtf(ss * (1.0f / 384.0f) + 1e-6f);
#pragma unroll
        for (int i = 0; i < 3; ++i) { const int col = lane * 2 + 128 * i; *(unsigned*)(cqn + (size_t)r * 384 + col) = pk2(a[2 * i] * rq * qn[col], a[2 * i + 1] * rq * qn[col + 1]); }
        float k4[4] = {lo_f(w2.x), hi_f(w2.x), lo_f(w2.y), hi_f(w2.y)};
        float s2 = k4[0] * k4[0] + k4[1] * k4[1] + k4[2] * k4[2] + k4[3] * k4[3]; s2 = wave_sum(s2); const float rk = rsqrtf(s2 * (1.0f / 256.0f) + 1e-6f);
        { const int col = lane * 4; u32x2 o; o.x = pk2(k4[0] * rk * kvn[col], k4[1] * rk * kvn[col + 1]); o.y = pk2(k4[2] * rk * kvn[col + 2], k4[3] * rk * kvn[col + 3]); *(u32x2*)(ckvn + (size_t)r * 256 + col) = o; }
        const float pv = __shfl_xor(v, 32);
        const float o = lane < 32 ? v * cs.x - pv * cs.y : v * cs.x + pv * cs.y;
        krope[(size_t)r * 64 + lane] = f2bf(o);
    }
}

__device__ __forceinline__ void rglru_tile(LAS unsigned char* lds, const Params& p, const bf16_t* zx, unsigned* lau, f32x2* summ, int gb, int tc, int n) {
    const int tid = opaque_tid(), wid = tid >> 6, lane = tid & 63, l15 = lane & 15, quad = lane >> 4;
    const bf16_t* WA = (const bf16_t*)(p.ws + O_WRGA) + (size_t)n * 128 * 128; const bf16_t* WI = (const bf16_t*)(p.ws + O_WRGI) + (size_t)n * 128 * 128;
    LAS unsigned char* xcs = lds;
    LAS unsigned* laus = (LAS unsigned*)(lds + 34816);
    LAS f32x2* segs = (LAS f32x2*)(lds + 34816 + 65536);
    const size_t tok0 = (size_t)gb * SEQ + tc * 128;
    const int e = wid * 16 + l15;
    bf16x8 fa[4], fi[4];
#pragma unroll
    for (int ks = 0; ks < 4; ++ks) { fa[ks] = *(const bf16x8*)(WA + (size_t)e * 128 + ks * 32 + quad * 8); fi[ks] = *(const bf16x8*)(WI + (size_t)e * 128 + ks * 32 + quad * 8); }
    const float bav = p.in[15][n * 128 + e], biv = p.in[17][n * 128 + e]; const float sp8 = -8.0f * log1pf(__expf(-p.in[18][n * 128 + e]));
    {
        const int cg8 = tid & 15, tg = tid >> 4, ch0 = n * 128 + cg8 * 8, t0 = tg * 4;
        float xin[7][8];
#pragma unroll
        for (int k = 0; k < 7; ++k) { const int t = t0 - 3 + k; u32x4 w = (u32x4){0u, 0u, 0u, 0u};
            if (tc * 128 + t >= 0) w = *(const u32x4*)(zx + (tok0 + t) * 1024 + ch0);
            xin[k][0] = lo_f(w.x); xin[k][1] = hi_f(w.x); xin[k][2] = lo_f(w.y); xin[k][3] = hi_f(w.y); xin[k][4] = lo_f(w.z); xin[k][5] = hi_f(w.z); xin[k][6] = lo_f(w.w); xin[k][7] = hi_f(w.w); }
        const float* cw = p.in[12]; const float* cb = p.in[13];
        float w0[8], w1[8], w2[8], w3[8], bb[8];
#pragma unroll
        for (int j = 0; j < 8; ++j) { w0[j] = cw[ch0 + j]; w1[j] = cw[1024 + ch0 + j]; w2[j] = cw[2048 + ch0 + j]; w3[j] = cw[3072 + ch0 + j]; bb[j] = cb[ch0 + j]; }
#pragma unroll
        for (int tt = 0; tt < 4; ++tt) { float o[8];
#pragma unroll
            for (int j = 0; j < 8; ++j) o[j] = w0[j] * xin[tt][j] + w1[j] * xin[tt + 1][j] + w2[j] * xin[tt + 2][j] + w3[j] * xin[tt + 3][j] + bb[j];
            u32x4 w; w.x = pk2(o[0], o[1]); w.y = pk2(o[2], o[3]); w.z = pk2(o[4], o[5]); w.w = pk2(o[6], o[7]);
            *(LAS u32x4*)(xcs + (t0 + tt) * 272 + cg8 * 16) = w; }
    }
    __syncthreads();
    {
#pragma unroll 2
        for (int tt = 0; tt < 8; ++tt) {
            f32x4 aa = (f32x4){0.f, 0.f, 0.f, 0.f}, ai = (f32x4){0.f, 0.f, 0.f, 0.f};
#pragma unroll
            for (int ks = 0; ks < 4; ++ks) { const bf16x8 af = *(const LAS bf16x8*)(xcs + (tt * 16 + l15) * 272 + ks * 64 + quad * 16);
                aa = __builtin_amdgcn_mfma_f32_16x16x32_bf16(af, fa[ks], aa, 0, 0, 0);
                ai = __builtin_amdgcn_mfma_f32_16x16x32_bf16(af, fi[ks], ai, 0, 0, 0); }
#pragma unroll
            for (int j = 0; j < 4; ++j) { const int t = tt * 16 + quad * 4 + j;
                const float r = sigmoidf_(aa[j] + bav), ig = sigmoidf_(ai[j] + biv);
                const float la = r * sp8; const float x2 = 2.0f * la;
                const float ser = -x2 * (1.0f + x2 * (0.5f + x2 * (0.16666667f + x2 * (0.041666667f + x2 * (0.0083333333f + x2 * 0.0013888889f)))));
                const float em = x2 > -0.3f ? ser : 1.0f - __expf(x2);
                const float xcv = bf2f(*(const LAS bf16_t*)(xcs + t * 272 + e * 2));
                const float uu = sqrtf(em) * ig * xcv;
                laus[t * 128 + e] = pk2(la, uu); }
        }
    }
    __syncthreads();
    {
        const int ch = tid & 127, seg = tid >> 7; float P = 1.f, H = 0.f;
#pragma unroll 4
        for (int t = seg * 32; t < seg * 32 + 32; ++t) { const unsigned w = laus[t * 128 + ch]; const float a = __expf(lo_f(w)); P *= a; H = a * H + hi_f(w); }
        segs[seg * 128 + ch] = (f32x2){P, H};
#pragma unroll
        for (int i = 0; i < 8; ++i) { const int id = i * 512 + tid, row = id >> 5, c4 = id & 31;
            *(u32x4*)(lau + (tok0 + row) * 1024 + n * 128 + c4 * 4) = *(const LAS u32x4*)(laus + row * 128 + c4 * 4); }
    }
    __syncthreads();
    if (tid < 128) { f32x2 s0 = segs[tid]; float P = s0.x, H = s0.y;
#pragma unroll
        for (int s = 1; s < 4; ++s) { const f32x2 sv = segs[s * 128 + tid]; H = sv.x * H + sv.y; P *= sv.x; }
        summ[(size_t)(gb * 16 + tc) * 1024 + n * 128 + tid] = (f32x2){P, H}; }
    __syncthreads();
}
__device__ __forceinline__ void scan_apply(const unsigned* __restrict__ lau, const f32x2* __restrict__ summ, const bf16_t* __restrict__ zg, bf16_t* __restrict__ yb, int gb, int tc, int half) {
    const int ch = half * 512 + opaque_tid(); float h = 0.f;
    const size_t base = ((size_t)gb * SEQ + tc * 128) * 1024 + ch;
    unsigned wv[16]; bf16_t gv[16];
#pragma unroll
    for (int i = 0; i < 16; ++i) { wv[i] = lau[base + (size_t)i * 1024]; gv[i] = zg[base + (size_t)i * 1024]; }
    f32x2 sv[15];
#pragma unroll
    for (int k = 0; k < 15; ++k) { sv[k] = (f32x2){1.f, 0.f}; if (k < tc) sv[k] = summ[(size_t)(gb * 16 + k) * 1024 + ch]; }
#pragma unroll
    for (int k = 0; k < 15; ++k) h = sv[k].x * h + sv[k].y;
#pragma unroll 1
    for (int tb = 0; tb < 8; ++tb) {
        unsigned wn[16]; bf16_t gn[16];
        if (tb < 7) {
#pragma unroll
            for (int i = 0; i < 16; ++i) { wn[i] = lau[base + (size_t)((tb + 1) * 16 + i) * 1024]; gn[i] = zg[base + (size_t)((tb + 1) * 16 + i) * 1024]; } }
#pragma unroll
        for (int i = 0; i < 16; ++i) { const float a = __expf(lo_f(wv[i])); h = a * h + hi_f(wv[i]); yb[base + (size_t)(tb * 16 + i) * 1024] = f2bf(h * bf2f(gv[i])); }
#pragma unroll
        for (int i = 0; i < 16; ++i) { wv[i] = wn[i]; gv[i] = gn[i]; }
    }
}

template <int DQK, int DV, int QT, int DK1, bool ROPE>
__device__ __forceinline__ void attn_item(LAS unsigned char* lds, const bf16_t* Q, int ldq, const bf16_t* K1, int ldk1, const bf16_t* K2, int ldk2,
                                          const bf16_t* Vt, int ldvt, bf16_t* O, int ldo, int ntiles, int wave_tiles, float c_scale, const f32x2* rope, int pos0) {
    constexpr int KSTR = DQK * 2 + 32, VSTR = 160, KBYTES = 64 * KSTR, BUF = KBYTES + DV * VSTR;
    static_assert(2 * BUF <= LDS_MAIN, "attention LDS");
    constexpr int NKS = DQK / 32, NDT = DV / 16, KCH = DQK / 8;
    constexpr int NKL = 64 * KCH / 512, NVL = DV * 8 / 512;
    const int tid = opaque_tid(), wid = tid >> 6, lane = tid & 63, l15 = lane & 15, quad = lane >> 4;
    const int wrow0 = wid * QT * 16;
    bf16x8 qf[QT][NKS];
#pragma unroll
    for (int qt = 0; qt < QT; ++qt) {
        const bf16_t* qp = Q + (size_t)(wrow0 + qt * 16 + l15) * ldq + quad * 8;
#pragma unroll
        for (int ks = 0; ks < NKS; ++ks) qf[qt][ks] = *(const bf16x8*)(qp + ks * 32);
        if (ROPE) {
            const f32x2* rp = rope + (size_t)(pos0 + wrow0 + qt * 16 + l15) * 32 + quad * 8;
            bf16x8 x1 = qf[qt][NKS - 2], x2 = qf[qt][NKS - 1];
#pragma unroll
            for (int e = 0; e < 8; ++e) { const f32x2 cs = rp[e]; const float a = bf2f((bf16_t)x1[e]), b = bf2f((bf16_t)x2[e]);
                x1[e] = (short)f2bf((a * cs.x - b * cs.y) * c_scale); x2[e] = (short)f2bf((b * cs.x + a * cs.y) * c_scale); }
            qf[qt][NKS - 2] = x1; qf[qt][NKS - 1] = x2;
        }
#pragma unroll
        for (int ks = 0; ks < (ROPE ? NKS - 2 : NKS); ++ks) { bf16x8 x = qf[qt][ks];
#pragma unroll
            for (int e = 0; e < 8; ++e) x[e] = (short)f2bf(bf2f((bf16_t)x[e]) * c_scale);
            qf[qt][ks] = x; }
    }
    f32x4 o[NDT][QT];
#pragma unroll
    for (int dt = 0; dt < NDT; ++dt)
#pragma unroll
        for (int qt = 0; qt < QT; ++qt) o[dt][qt] = (f32x4){0.f, 0.f, 0.f, 0.f};
    float mrow[QT], lrow[QT];
#pragma unroll
    for (int qt = 0; qt < QT; ++qt) { mrow[qt] = -1e30f; lrow[qt] = 0.f; }

    constexpr int C1 = DK1 / 8, C2 = (DQK - DK1) / 8, NK1 = 64 * C1 / 512, NK2 = 64 * C2 / 512;
    static_assert(NK1 * 512 == 64 * C1 && NK2 * 512 == 64 * C2 && NK1 + NK2 == NKL, "chunking");
    u32x4 kst1[NK1], kst2[NK2 ? NK2 : 1], vst[NVL];
    unsigned k1o[NK1], k2o[NK2 ? NK2 : 1], vo[NVL];
#pragma unroll
    for (int i = 0; i < NK1; ++i) { const int ci = tid + 512 * i; k1o[i] = (unsigned)((ci / C1) * ldk1 + (ci % C1) * 8); }
#pragma unroll
    for (int i = 0; i < NK2; ++i) { const int ci = tid + 512 * i; k2o[i] = (unsigned)((ci / (C2 ? C2 : 1)) * ldk2 + (ci % (C2 ? C2 : 1)) * 8); }
#pragma unroll
    for (int i = 0; i < NVL; ++i) { const int ci = tid + 512 * i; vo[i] = (unsigned)((ci >> 3) * ldvt + (ci & 7) * 8); }
#define ATT_LOAD(j) do { const bf16_t* k1p = K1 + (size_t)(j) * 64 * ldk1; const bf16_t* k2p = K2 + (size_t)(j) * 64 * ldk2; const bf16_t* vp_ = Vt + (size_t)(j) * 64; \
        _Pragma("unroll") for (int i = 0; i < NK1; ++i) kst1[i] = *(const u32x4*)(k1p + k1o[i]); \
        _Pragma("unroll") for (int i = 0; i < NK2; ++i) kst2[i] = *(const u32x4*)(k2p + k2o[i]); \
        _Pragma("unroll") for (int i = 0; i < NVL; ++i) vst[i] = *(const u32x4*)(vp_ + vo[i]); } while (0)
#define KSLOT(k) ((((k) >> 5) * 2 + (((k) >> 2) & 1)) * 16 + (((k) >> 3) & 3) * 4 + ((k) & 3))
#define ATT_WRITE(b) do { LAS unsigned char* kb_ = lds + (b) * BUF; \
        _Pragma("unroll") for (int i = 0; i < NK1; ++i) { const int ci = tid + 512 * i; *(LAS u32x4*)(kb_ + KSLOT(ci / C1) * KSTR + (ci % C1) * 16) = kst1[i]; } \
        _Pragma("unroll") for (int i = 0; i < NK2; ++i) { const int ci = tid + 512 * i; *(LAS u32x4*)(kb_ + KSLOT(ci / (C2 ? C2 : 1)) * KSTR + DK1 * 2 + (ci % (C2 ? C2 : 1)) * 16) = kst2[i]; } \
        _Pragma("unroll") for (int i = 0; i < NVL; ++i) { const int ci = tid + 512 * i; *(LAS u32x4*)(kb_ + KBYTES + (ci >> 3) * VSTR + (ci & 7) * 16) = vst[i]; } } while (0)
    ATT_LOAD(0); ATT_WRITE(0);
    __syncthreads();
    for (int j = 0; j < ntiles; ++j) {
        const bool more = (j + 1 < ntiles);
        if (more) ATT_LOAD(j + 1);
        __builtin_amdgcn_sched_barrier(0);
        if (j < wave_tiles) {
            const LAS unsigned char* kb = lds + (j & 1) * BUF; const LAS unsigned char* vb = kb + KBYTES;
            f32x4 s[4][QT];
#pragma unroll
            for (int kt = 0; kt < 4; ++kt)
#pragma unroll
                for (int qt = 0; qt < QT; ++qt) s[kt][qt] = (f32x4){0.f, 0.f, 0.f, 0.f};
            {
                bf16x8 kf[2][4];
#pragma unroll
                for (int kt = 0; kt < 4; ++kt) kf[0][kt] = *(const LAS bf16x8*)(kb + (kt * 16 + l15) * KSTR + quad * 16);
#pragma unroll
                for (int ks = 0; ks < NKS; ++ks) {
                    if (ks + 1 < NKS) {
#pragma unroll
                        for (int kt = 0; kt < 4; ++kt) kf[(ks + 1) & 1][kt] = *(const LAS bf16x8*)(kb + (kt * 16 + l15) * KSTR + (ks + 1) * 64 + quad * 16); }
#pragma unroll
                    for (int kt = 0; kt < 4; ++kt)
#pragma unroll
                        for (int qt = 0; qt < QT; ++qt) s[kt][qt] = __builtin_amdgcn_mfma_f32_16x16x32_bf16(kf[ks & 1][kt], qf[qt][ks], s[kt][qt], 0, 0, 0);
                    __builtin_amdgcn_sched_barrier(0);
                }
            }
            bf16x8 pf[QT][2];
#pragma unroll
            for (int qt = 0; qt < QT; ++qt) {
                float mx = -1e30f;
#pragma unroll
                for (int kt = 0; kt < 4; ++kt)
#pragma unroll
                    for (int jj = 0; jj < 4; ++jj) mx = fmaxf(mx, s[kt][qt][jj]);
                if (__builtin_amdgcn_ballot_w64(mx > mrow[qt] + 8.0f) != 0ull) {
                    mx = fmaxf(mx, __shfl_xor(mx, 16)); mx = fmaxf(mx, __shfl_xor(mx, 32));
                    const float mnew = fmaxf(mrow[qt], mx); const float alpha = __builtin_amdgcn_exp2f(mrow[qt] - mnew); mrow[qt] = mnew; lrow[qt] *= alpha;
#pragma unroll
                    for (int dt = 0; dt < NDT; ++dt) o[dt][qt] = o[dt][qt] * alpha; }
                const float mcur = mrow[qt];
                float ps = 0.f;
#pragma unroll
                for (int kt = 0; kt < 4; ++kt)
#pragma unroll
                    for (int jj = 0; jj < 4; ++jj) { const float pv = __builtin_amdgcn_exp2f(s[kt][qt][jj] - mcur); s[kt][qt][jj] = pv; ps += pv; }
                lrow[qt] += ps;
#pragma unroll
                for (int s2 = 0; s2 < 2; ++s2) { u32x4 w; w.x = pk2(s[2 * s2][qt][0], s[2 * s2][qt][1]); w.y = pk2(s[2 * s2][qt][2], s[2 * s2][qt][3]);
                    w.z = pk2(s[2 * s2 + 1][qt][0], s[2 * s2 + 1][qt][1]); w.w = pk2(s[2 * s2 + 1][qt][2], s[2 * s2 + 1][qt][3]); pf[qt][s2] = __builtin_bit_cast(bf16x8, w); }
            }
            {
                constexpr int NST = 2 * (NDT / 4);
                bf16x8 vf[2][4];
#define ATT_VLOAD(buf, st) do { const int s2_ = (st) / (NDT / 4), dg_ = (st) % (NDT / 4); _Pragma("unroll") for (int d4 = 0; d4 < 4; ++d4) \
                    vf[buf][d4] = *(const LAS bf16x8*)(vb + ((dg_ * 4 + d4) * 16 + l15) * VSTR + s2_ * 64 + quad * 16); } while (0)
                ATT_VLOAD(0, 0);
#pragma unroll
                for (int st = 0; st < NST; ++st) {
                    if (st + 1 < NST) ATT_VLOAD((st + 1) & 1, st + 1);
                    const int s2 = st / (NDT / 4), dg = st % (NDT / 4);
#pragma unroll
                    for (int d4 = 0; d4 < 4; ++d4)
#pragma unroll
                        for (int qt = 0; qt < QT; ++qt) o[dg * 4 + d4][qt] = __builtin_amdgcn_mfma_f32_16x16x32_bf16(vf[st & 1][d4], pf[qt][s2], o[dg * 4 + d4][qt], 0, 0, 0);
                    __builtin_amdgcn_sched_barrier(0);
                }
#undef ATT_VLOAD
            }
        }
        if (more) ATT_WRITE((j + 1) & 1);
        __syncthreads();
    }
#undef ATT_LOAD
#undef ATT_WRITE
#undef KSLOT
#pragma unroll
    for (int qt = 0; qt < QT; ++qt) {
        float l = lrow[qt]; l += __shfl_xor(l, 16); l += __shfl_xor(l, 32); const float inv = 1.0f / l;
        bf16_t* op = O + (size_t)(wrow0 + qt * 16 + l15) * ldo + quad * 4;
#pragma unroll
        for (int dt = 0; dt < NDT; ++dt) { u32x2 w; w.x = pk2(o[dt][qt][0] * inv, o[dt][qt][1] * inv); w.y = pk2(o[dt][qt][2] * inv, o[dt][qt][3] * inv); *(u32x2*)(op + dt * 16) = w; }
    }
}


#define XB_TMO      128
#define XB_XCNT(j)  (256  + 64 * (j))
#define XB_XSUB(j)  (1280 + 64 * (j))
#define XB_XGEN(j)  (2304 + 64 * (j))
#define XB_TOP      3328
#define XB_TOPGEN   3392
#define XCD_BAR_WORDS 3456
#define XB_SPIN_CAP (1u << 22)
__device__ __forceinline__ unsigned xb_ld(unsigned* p)              { return __hip_atomic_load(p, __ATOMIC_RELAXED, __HIP_MEMORY_SCOPE_AGENT); }
__device__ __forceinline__ unsigned xb_add(unsigned* p, unsigned v) { return __hip_atomic_fetch_add(p, v, __ATOMIC_RELAXED, __HIP_MEMORY_SCOPE_AGENT); }
__device__ __forceinline__ unsigned xb_xcc_id() { return (unsigned)__builtin_amdgcn_s_getreg((3 << 11) | 20) & 0xFu; }
#define XB_SPIN(cond, bar) do { unsigned _sp = 0; while (cond) { __builtin_amdgcn_s_sleep(1); \
    if ((++_sp & 255u) == 0u) { if (xb_ld(&(bar)[XB_TMO])) break; if (_sp > XB_SPIN_CAP) { atomicAdd(&(bar)[XB_TMO], 1u); break; } } } } while (0)
struct XcdBarrier { unsigned* bar; unsigned x; volatile LAS unsigned* st; };
__device__ __forceinline__ XcdBarrier xcd_barrier_post(unsigned* bar, volatile LAS unsigned* st) {
    XcdBarrier b; b.bar = bar; b.x = xb_xcc_id(); b.st = st;
    if (threadIdx.x == 0) (void)xb_add(&bar[XB_XCNT(b.x)], 1u);
    return b;
}
__device__ __forceinline__ void xcd_barrier_complete(unsigned* bar, unsigned x, unsigned& nloc, unsigned& nx) {
    const unsigned G = gridDim.x * gridDim.y * gridDim.z;
    unsigned sum, cnt, mine, sp = 0u;
    for (;;) {
        sum = 0u; cnt = 0u; mine = 0u;
#pragma unroll
        for (unsigned j = 0; j < 16; ++j) { const unsigned c = xb_ld(&bar[XB_XCNT(j)]); sum += c; cnt += (c > 0u) ? 1u : 0u; mine = (j == x) ? c : mine; }
        if (sum == G) break;
        __builtin_amdgcn_s_sleep(1);
        if ((++sp & 255u) == 0u) { if (xb_ld(&bar[XB_TMO])) break; if (sp > XB_SPIN_CAP) { atomicAdd(&bar[XB_TMO], 1u); break; } }
    }
    nloc = mine > 0u ? mine : 1u; nx = cnt > 0u ? cnt : 1u;
}
__device__ __forceinline__ void xcd_barrier(const XcdBarrier& b) {
    asm volatile("s_waitcnt vmcnt(0)" ::: "memory");
    __syncthreads();
    if (threadIdx.x == 0) {
        unsigned* bar = b.bar;
        __builtin_amdgcn_s_waitcnt(0);
        unsigned nloc = b.st[0], nx = b.st[1];
        if (nloc == 0u) { xcd_barrier_complete(bar, b.x, nloc, nx); b.st[0] = nloc; b.st[1] = nx; }
        const unsigned old = xb_add(&bar[XB_XSUB(b.x)], 1u);
        const unsigned gen = old / nloc;
        if (old + 1u == (gen + 1u) * nloc) {
            __builtin_amdgcn_fence(__ATOMIC_RELEASE, "agent");
            asm volatile("s_waitcnt vmcnt(0)" ::: "memory");
            const unsigned og = xb_add(&bar[XB_TOP], 1u);
            const unsigned tg = og / nx;
            if (og + 1u == (tg + 1u) * nx) xb_add(&bar[XB_TOPGEN], 1u);
            else XB_SPIN(xb_ld(&bar[XB_TOPGEN]) == tg, bar);
            __builtin_amdgcn_fence(__ATOMIC_ACQUIRE, "agent");
            xb_add(&bar[XB_XGEN(b.x)], 1u);
            asm volatile("s_waitcnt vmcnt(0)" ::: "memory");
        } else {
            XB_SPIN(xb_ld(&bar[XB_XGEN(b.x)]) == gen, bar);
            __builtin_amdgcn_fence(__ATOMIC_ACQUIRE, "agent");
            asm volatile("s_waitcnt vmcnt(0)" ::: "memory");
        }
    }
    __syncthreads();
}

#define WT_JOBS(COND, WGT) \
_Pragma("unroll 1") \
        for (int job = 0; job < 31; ++job) { if (!(COND)) continue; \
            const float* src; int sld, K, Np, map; size_t doff; \
            if (job == 0)      { src = p.in[3];  sld = 5632; doff = O_W1IN;  K = 1024; Np = 5632; map = 1; } \
            else if (job == 1) { src = p.in[4];  sld = 1024; doff = O_W1DN;  K = 2816; Np = 1024; map = 0; } \
            else if (job == 2) { src = p.in[24]; sld = 5632; doff = O_W2IN;  K = 1024; Np = 5632; map = 1; } \
            else if (job == 3) { src = p.in[25]; sld = 1024; doff = O_W2DN;  K = 2816; Np = 1024; map = 0; } \
            else if (job == 4) { src = p.in[6];  sld = INW;  doff = O_WINA;  K = 1024; Np = 3840; map = 2; } \
            else if (job == 5) { src = p.in[6];  sld = INW;  doff = O_WGATE; K = 1024; Np = 3072; map = 3; } \
            else if (job == 6) { src = p.in[9];  sld = 1536; doff = O_WUQ;   K = 384;  Np = 1536; map = 0; } \
            else if (job == 7) { src = p.in[11]; sld = 2048; doff = O_WUK;   K = 256;  Np = 1024; map = 4; } \
            else if (job == 8) { src = p.in[11]; sld = 2048; doff = O_WUV;   K = 256;  Np = 1024; map = 5; } \
            else if (job == 9) { src = p.in[20]; sld = 2048; doff = O_WMK;   K = 1024; Np = 1024; map = 0; } \
            else if (job == 10) { src = p.in[20]; sld = 2048; doff = O_WMV;  K = 1024; Np = 1024; map = 6; } \
            else if (job < 14) { const int b = job - 11; src = p.in[21] + (size_t)b * D * D; sld = 1024; doff = O_WBR + (size_t)b * D * D * 2; K = 1024; Np = 1024; map = 0; } \
            else if (job == 14) { src = p.in[22]; sld = 1024; doff = O_WOUT; K = 1024; Np = 1024; map = 0; } \
            else if (job < 23) { const int n = job - 15; src = p.in[14] + n * 16384; sld = 128; doff = O_WRGA + (size_t)n * 32768; K = 128; Np = 128; map = 0; } \
            else { const int n = job - 23; src = p.in[16] + n * 16384; sld = 128; doff = O_WRGI + (size_t)n * 32768; K = 128; Np = 128; map = 0; } \
            wt_job<WGT>(src, sld, (bf16_t*)(ws + doff), K, Np, map, lds, G, c); \
        } \
        f32x2* rope = (f32x2*)(ws + O_ROPE); \

constexpr int N_PHASES = 20;
__global__ void __launch_bounds__(512, 2) mega(Params p) {
    extern __shared__ __attribute__((aligned(16))) unsigned char smem[];
    LAS unsigned char* lds = (LAS unsigned char*)smem;
    cg::grid_group grid = cg::this_grid();
    const int G = gridDim.x, c = blockIdx.x, tid = threadIdx.x;
    unsigned char* ws = p.ws;
#ifndef PH_MASK
#define PH_MASK 0xFFFFF
#endif
#ifndef REP_MASK
#define REP_MASK 0
#endif
#define REPS(k) for (int rep_ = 0; rep_ < (int)((REP_MASK >> (k)) & 1) + 1; ++rep_)
#define IN(k) (((PH_MASK >> (k)) & 1) && p.ph_lo <= (k) && (k) < p.ph_hi)
#define INM(j) (((PH_MASK >> (4 + (j))) & 1) && p.ph_lo <= (ph + (j)) && (ph + (j)) < p.ph_hi)
#define SEAM(k) do { if (p.ph_lo <= (k) && (k) + 1 < p.ph_hi) { xcd_barrier(xbar); } } while (0)
    bf16_t* Hb = (bf16_t*)(ws + O_H);
    if (tid < 4) ((LAS unsigned*)(lds + LDS_MAIN))[tid] = 0u;
    __syncthreads();
    XcdBarrier xbar = xcd_barrier_post((unsigned*)(ws + O_BAR), (volatile LAS unsigned*)(lds + LDS_MAIN));

    if (IN(0)) REPS(0) {
        WT_JOBS(job == 0 || job == 9 || job == 10, false);
        for (int i = c * 512 + tid; i < SEQ * 32; i += G * 512) { const int pos = i >> 5, fi = i & 31;
            const float inv = 1.0f / powf(10000.0f, (float)(2 * fi) / 64.0f); const float ang = (float)pos * inv; rope[i] = (f32x2){cosf(ang), sinf(ang)}; }
        rmsnorm_rows_bf16(p.in[1], p.in[19], (bf16_t*)(ws + O_MEMN), TMEM, G, c);
        rmsnorm_rows_bf16(p.in[0], p.in[2], Hb, T, G, c);
    }
    if (p.ph_lo < 0) grid.sync();
    SEAM(0);
    if (IN(1)) REPS(1) {
        pg8::Sched3 S{Hb, (const bf16_t*)(ws + O_W1IN), (const bf16_t*)(ws + O_MEMN), (const bf16_t*)(ws + O_WMK), (const bf16_t*)(ws + O_WMV), (const bf16_t*)(ws + O_MEMN),
                      T / 256, 22, TMEM / 256, 4, 4, TMEM / 256, G, c, 1024};
        pg8::EpiFfnIn E{(bf16_t*)(ws + O_HID), (bf16_t*)(ws + O_MEMK), (bf16_t*)(ws + O_MEMVT)};
        pg8::gemm_phase(lds, 1024, S, E);
        WT_JOBS(!(job == 0 || job == 9 || job == 10), true);
    }
    SEAM(1);
    if (IN(2)) REPS(2) {
        pg8::Sched3 S{(const bf16_t*)(ws + O_HID), (const bf16_t*)(ws + O_W1DN), nullptr, nullptr, nullptr, nullptr, T / 256, 4, 0, 0, 0, 0, G, c, FF};
        pg8::EpiResid E{p.in[0], p.out, 0.5f};
        pg8::gemm_phase(lds, FF, S, E);
    }
    SEAM(2);
    if (IN(3)) REPS(3) rmsnorm_rows_bf16(p.out, p.in[5], Hb, T, G, c);
    SEAM(3);
    bf16_t* zx = (bf16_t*)(ws + O_ZX); bf16_t* zg = (bf16_t*)(ws + O_ZG); bf16_t* zmq = (bf16_t*)(ws + O_ZMQ); bf16_t* zl = (bf16_t*)(ws + O_ZL);
    bf16_t* cqn = (bf16_t*)(ws + O_CQN); bf16_t* ckvn = (bf16_t*)(ws + O_CKVN); bf16_t* krope = (bf16_t*)(ws + O_KROPE);
    unsigned* lau = (unsigned*)(ws + O_LAU); f32x2* summ = (f32x2*)(ws + O_SUMM);
    bf16_t* qb = (bf16_t*)(ws + O_Q); bf16_t* knope = (bf16_t*)(ws + O_KNOPE); bf16_t* vt = (bf16_t*)(ws + O_VT);
    bf16_t* ya = (bf16_t*)(ws + O_LAU); bf16_t* yb = zx; bf16_t* yc = zmq;
    bf16_t* gtmp = zg; float* mrg = (float*)(ws + O_Q); bf16_t* merged = (bf16_t*)(ws + O_VT);
    const f32x2* rope = (const f32x2*)(ws + O_ROPE);
#pragma unroll 1
    for (int g = 0; g < NG; ++g) {
        const int ph = 4 + 6 * g;
        const bf16_t* h2g = Hb + (size_t)g * TG * D;
        if (INM(0)) REPS(4) {
            pg8::Sched3 S{h2g, (const bf16_t*)(ws + O_WINA), nullptr, nullptr, nullptr, nullptr, TG / 256, 15, 0, 0, 0, 0, G, c, 1024};
            pg8::EpiInProj E{zx, zg, zmq, zl};
            pg8::gemm_phase(lds, 1024, S, E);
        }
        SEAM(ph);
        if (INM(1)) REPS(5) {
            for (int it = c; it < GB * 16 * 8; it += G) { const int n = it & 7, tc = (it >> 3) & 15, gb = it >> 7; rglru_tile(lds, p, zx, lau, summ, gb, tc, n); }
            latent_rows(zl, p.in[8], p.in[10], rope, cqn, ckvn, krope, G, c);
        }
        SEAM(ph + 1);
        if (INM(2)) REPS(6) {
            { pg8::Sched3 S{cqn, (const bf16_t*)(ws + O_WUQ), nullptr, nullptr, nullptr, nullptr, TG / 256, 6, 0, 0, 0, 0, G, c, 384};
              pg8::EpiPlain1 E{qb, 1536}; pg8::gemm_phase(lds, 384, S, E); }
            { pg8::Sched3 S{ckvn, (const bf16_t*)(ws + O_WUK), nullptr, nullptr, nullptr, nullptr, TG / 256, 4, 0, 0, 0, 0, G, G - 1 - c, 256};
              pg8::EpiPlain1 E{knope, 1024}; pg8::gemm_phase(lds, 256, S, E); }
            const int Gv = (G == 256) ? 128 : G, cv = (G == 256) ? (c >= 128 ? c - 128 : (1 << 20)) : c;
            { pg8::Sched3 S{(const bf16_t*)(ws + O_WUV), ckvn, nullptr, nullptr, nullptr, nullptr, 4, TG / 256, 0, 0, 0, 0, Gv, cv, 256};
              pg8::EpiPlain1 E{vt, TG}; pg8::gemm_phase(lds, 256, S, E); }
            for (int it = c; it < GB * 16 * 2; it += G) { const int half = it & 1, tc = (it >> 1) & 15, gb = it >> 5; scan_apply(lau, summ, zg, yb, gb, tc, half); }
        }
        SEAM(ph + 2);
        if (INM(3)) {
#ifndef ATT_SEL
#define ATT_SEL 3
#endif
            if (ATT_SEL & 1) REPS(7) for (int pr0 = c; pr0 < GB * 8 * 4; pr0 += G) {
                const int pr = (G == 256) ? (((pr0 & 7) << 5) | (pr0 >> 3)) : pr0;
                const int qp = pr & 3, h = (pr >> 2) & 7, gb = pr >> 5;
#pragma unroll 1
                for (int w = 0; w < 2; ++w) { const int qblk = w == 0 ? 7 - qp : qp; const size_t tok0 = (size_t)gb * SEQ + qblk * 256;
                    attn_item<192, 128, 2, 128, true>(lds, qb + tok0 * 1536 + h * 192, 1536, knope + (size_t)gb * SEQ * 1024 + h * 128, 1024, krope + (size_t)gb * SEQ * 64, 64,
                        vt + (size_t)h * 128 * TG + (size_t)gb * SEQ, TG, ya + tok0 * 1024 + h * 128, 1024, 4 * qblk + 4, 4 * qblk + (tid >> 7) + 1,
                        0.07216878364870322f * 1.4426950408889634f, rope, qblk * 256); }
            }
            if (ATT_SEL & 2) for (int it = c; it < GB * 4 * 16; it += G) {
                const int qblk = it & 15, h = (it >> 4) & 3, gb = it >> 6; const int bglob = g * GB + gb; const size_t tok0 = (size_t)gb * SEQ + qblk * 128;
                attn_item<256, 256, 1, 256, false>(lds, zmq + tok0 * 1024 + h * 256, 1024, (const bf16_t*)(ws + O_MEMK) + (size_t)bglob * NMEM * 1024 + h * 256, 1024, nullptr, 0,
                    (const bf16_t*)(ws + O_MEMVT) + (size_t)h * 256 * TMEM + (size_t)bglob * NMEM, TMEM, yc + tok0 * 1024 + h * 256, 1024, 4, 4, 0.0625f * 1.4426950408889634f, rope, 0);
            }
        }
        SEAM(ph + 3);
        if (INM(4)) REPS(8) {
            pg8::SchedMerge S{ws, O_H + (size_t)g * TG * D * 2, G, c};
            pg8::EpiMerge E{gtmp, mrg, merged, p.in[7]};
            pg8::gemm_phase(lds, 1024, S, E);
        }
        SEAM(ph + 4);
        if (INM(5)) {
            pg8::Sched3 S{merged, (const bf16_t*)(ws + O_WOUT), nullptr, nullptr, nullptr, nullptr, TG / 256, 4, 0, 0, 0, 0, G, c, 1024};
            float* xo = p.out + (size_t)g * TG * D;
            pg8::EpiResid E{xo, xo, 1.0f};
            pg8::gemm_phase(lds, 1024, S, E);
        }
        if (g == NG - 1) SEAM(ph + 5);
    }
    if (IN(16)) REPS(16) rmsnorm_rows_bf16(p.out, p.in[23], Hb, T, G, c);
    SEAM(16);
    if (IN(17)) REPS(17) {
        pg8::Sched3 S{Hb, (const bf16_t*)(ws + O_W2IN), nullptr, nullptr, nullptr, nullptr, T / 256, 22, 0, 0, 0, 0, G, c, 1024};
        pg8::EpiFfnIn E{(bf16_t*)(ws + O_HID), nullptr, nullptr};
        pg8::gemm_phase(lds, 1024, S, E);
    }
    SEAM(17);
    if (IN(18)) {
        pg8::Sched3 S{(const bf16_t*)(ws + O_HID), (const bf16_t*)(ws + O_W2DN), nullptr, nullptr, nullptr, nullptr, T / 256, 4, 0, 0, 0, 0, G, c, FF};
        pg8::EpiResid E{p.out, p.out, 0.5f};
        pg8::gemm_phase(lds, FF, S, E);
    }
    SEAM(18);
    if (IN(19)) rmsnorm_rows_f32_inplace(p.out, p.in[26], T, G, c);
#undef IN
#undef INM
#undef SEAM
}

extern "C" void kernel_launch(void* const* d_in, const int* in_sizes, int n_in, void* d_out, int out_size, void* d_ws, size_t ws_size, hipStream_t stream) {
    static int grid = 0;
    if (grid == 0) {
        int dev = 0, cus = 0, per_cu = 0;
        hipGetDevice(&dev);
        hipDeviceGetAttribute(&cus, hipDeviceAttributeMultiprocessorCount, dev);
        hipFuncSetAttribute((const void*)mega, hipFuncAttributeMaxDynamicSharedMemorySize, LDS_BYTES);
        hipOccupancyMaxActiveBlocksPerMultiprocessor(&per_cu, (const void*)mega, 512, LDS_BYTES);
        if (per_cu < 1) { fprintf(stderr, "occupancy query returned %d\n", per_cu); per_cu = 1; }
        grid = cus * 1;
        if (ws_size < O_END) { fprintf(stderr, "workspace too small: %zu < %zu\n", ws_size, (size_t)O_END); grid = -1; }
    }
    if (grid < 0) return;
    Params p{};
    for (int i = 0; i < 27; ++i) p.in[i] = (const float*)d_in[i];
    p.out = (float*)d_out; p.ws = (unsigned char*)d_ws;
#if MK_ONE_LAUNCH
    p.ph_lo = 0; p.ph_hi = N_PHASES;
    (void)hipMemsetAsync((unsigned char*)d_ws + O_BAR, 0, XCD_BAR_WORDS * 4, stream);
    void* args[] = {&p};
    hipError_t e = hipLaunchCooperativeKernel((const void*)mega, dim3(grid), dim3(512), args, LDS_BYTES, stream);
    if (e != hipSuccess) fprintf(stderr, "cooperative launch failed: %s (grid %d)\n", hipGetErrorString(e), grid);
#else
    for (int k = 0; k < N_PHASES; ++k) { p.ph_lo = k; p.ph_hi = k + 1; hipLaunchKernelGGL(mega, dim3(grid), dim3(512), LDS_BYTES, stream, p); }
#endif
}
```

```cpp
#include <hip/hip_runtime.h>
#include <hip/hip_cooperative_groups.h>
#include <cstdio>
namespace cg = cooperative_groups;

#ifndef MK_ONE_LAUNCH
#define MK_ONE_LAUNCH 1
#endif

#define LAS __attribute__((address_space(3)))
typedef unsigned short bf16_t;
typedef short bf16x8 __attribute__((ext_vector_type(8)));
typedef short bf16x4 __attribute__((ext_vector_type(4)));
typedef float f32x4 __attribute__((ext_vector_type(4)));
typedef float f32x2 __attribute__((ext_vector_type(2)));
typedef unsigned u32x4 __attribute__((ext_vector_type(4)));
typedef unsigned u32x2 __attribute__((ext_vector_type(2)));

constexpr int D = 1024, T = 32768, SEQ = 2048, FF = 2816, NBATCH = 16;
constexpr int GB = 8, TG = GB * SEQ, NG = NBATCH / GB;
constexpr int NMEM = 256, TMEM = NBATCH * NMEM;
constexpr int INW = 6848;

constexpr size_t MiB = 1u << 20;
constexpr size_t O_W1IN = 0;
constexpr size_t O_W1DN = O_W1IN + (size_t)5632 * 1024 * 2;
constexpr size_t O_W2IN = O_W1DN + (size_t)1024 * 2816 * 2;
constexpr size_t O_W2DN = O_W2IN + (size_t)5632 * 1024 * 2;
constexpr size_t O_WINA = O_W2DN + (size_t)1024 * 2816 * 2;
constexpr size_t O_WGATE = O_WINA + (size_t)3840 * 1024 * 2;
constexpr size_t O_WUQ = O_WGATE + (size_t)3072 * 1024 * 2;
constexpr size_t O_WUK = O_WUQ + (size_t)1536 * 384 * 2;
constexpr size_t O_WUV = O_WUK + (size_t)1024 * 256 * 2;
constexpr size_t O_WMK = O_WUV + (size_t)1024 * 256 * 2;
constexpr size_t O_WMV = O_WMK + (size_t)1024 * 1024 * 2;
constexpr size_t O_WBR = O_WMV + (size_t)1024 * 1024 * 2;
constexpr size_t O_WOUT = O_WBR + (size_t)3 * 1024 * 1024 * 2;
constexpr size_t O_WRGA = O_WOUT + (size_t)1024 * 1024 * 2;
constexpr size_t O_WRGI = O_WRGA + (size_t)8 * 128 * 128 * 2;
constexpr size_t O_ROPE = O_WRGI + (size_t)8 * 128 * 128 * 2;
constexpr size_t O_MEMK = O_ROPE + (size_t)2048 * 32 * 8;
constexpr size_t O_MEMVT = O_MEMK + (size_t)TMEM * 1024 * 2;
constexpr size_t O_R = ((O_MEMVT + (size_t)TMEM * 1024 * 2 + MiB - 1) / MiB) * MiB;
constexpr size_t O_H = O_R;
constexpr size_t O_HID = O_H + 64 * MiB;
constexpr size_t O_MEMN = O_HID + 176 * MiB;
constexpr size_t O_ZX = O_H + 64 * MiB;
constexpr size_t O_ZG = O_ZX + 32 * MiB;
constexpr size_t O_ZMQ = O_ZG + 32 * MiB;
constexpr size_t O_ZL = O_ZMQ + 32 * MiB;
constexpr size_t O_CQN = O_ZL + 24 * MiB;
constexpr size_t O_CKVN = O_CQN + 12 * MiB;
constexpr size_t O_KROPE = O_CKVN + 8 * MiB;
constexpr size_t O_LAU = O_KROPE + 2 * MiB;
constexpr size_t O_SUMM = O_LAU + 64 * MiB;
constexpr size_t O_Q = O_SUMM + 1 * MiB;
constexpr size_t O_KNOPE = O_Q + 48 * MiB;
constexpr size_t O_VT = O_KNOPE + 32 * MiB;
constexpr size_t O_BAR = O_VT + 32 * MiB;
constexpr size_t O_END = O_BAR + 65536;
static_assert(O_END <= 512 * MiB, "workspace");
static_assert(O_MEMN + 8 * MiB <= 512 * MiB, "workspace");

constexpr int LDS_MAIN = 151552;
constexpr int LDS_BYTES = LDS_MAIN + 16;

__device__ __forceinline__ float bf2f(bf16_t b) { return __uint_as_float(((unsigned)b) << 16); }
__device__ __forceinline__ bf16_t f2bf(float f) { unsigned u = __float_as_uint(f); u += 0x7FFFu + ((u >> 16) & 1u); return (bf16_t)(u >> 16); }
typedef __bf16 bf16v2 __attribute__((ext_vector_type(2)));
__device__ __forceinline__ unsigned pk2(float lo, float hi) { const f32x2 v = {lo, hi}; const bf16v2 b = __builtin_convertvector(v, bf16v2); return __builtin_bit_cast(unsigned, b); }
__device__ __forceinline__ float lo_f(unsigned w) { return __uint_as_float(w << 16); }
__device__ __forceinline__ float hi_f(unsigned w) { return __uint_as_float(w & 0xffff0000u); }
__device__ __forceinline__ float sigmoidf_(float x) { return __builtin_amdgcn_rcpf(1.0f + __expf(-x)); }
__device__ __forceinline__ float gelu_tanh(float x) { const float t = 1.5957691216f * (x + 0.044715f * x * x * x); return x * __builtin_amdgcn_rcpf(1.0f + __expf(-t)); }
__device__ __forceinline__ float wave_sum(float v) { v += __shfl_xor(v, 32); v += __shfl_xor(v, 16); v += __shfl_xor(v, 8); v += __shfl_xor(v, 4); v += __shfl_xor(v, 2); v += __shfl_xor(v, 1); return v; }

__device__ __forceinline__ int opaque_tid() { int t = threadIdx.x; asm volatile("" : "+v"(t)); return t; }
struct Params { const float* in[27]; float* out; unsigned char* ws; int ph_lo, ph_hi; };

namespace pg8 {
constexpr int BM = 256, BK = 64, HALF = 128, HTB = HALF * BK * 2, NXCD = 8, WGM = 4;
__device__ __forceinline__ int lds_byte(int r, int c) { const int st = (r >> 4) * 2 + (c >> 5), rr = r & 15, cc = c & 31, ob = rr * 64 + cc * 2; return st * 1024 + (ob ^ (((ob >> 9) & 1) << 5)); }
__device__ __forceinline__ void stage_rc(int b, int& R, int& C) { const int st = b / 1024, sb = b % 1024, swz = sb ^ (((sb >> 9) & 1) << 5); R = (st >> 1) * 16 + swz / 64; C = (st & 1) * 32 + (swz % 64) / 2; }
__device__ __forceinline__ int perm32(int rho) { const int n = rho >> 4, i = rho & 15; return 8 * (i >> 2) + 4 * n + (i & 3); }

struct Unit { const char* A; const char* B; int pm, pn, aux; };

__device__ __forceinline__ void tile_of(int L, int nM, int nN, int& pm, int& pn) {
    const int nwg = nM * nN; int wgid = L;
    { const int q = nwg / NXCD, r = nwg % NXCD, xcd = wgid % NXCD, off = wgid / NXCD; wgid = (xcd < r ? xcd * (q + 1) : r * (q + 1) + (xcd - r) * q) + off; }
    const int nig = WGM * nN, gid = wgid / nig, fm = gid * WGM, gsz = (nM - fm) < WGM ? (nM - fm) : WGM;
    pm = fm + ((wgid % nig) % gsz); pn = (wgid % nig) / gsz;
}
struct Sched3 {
    const bf16_t *A0, *B0, *A1, *B1, *A2, *B2; int nM0, nN0, nM1, nN1, nM2, nN2; int G, c, K;
    __device__ __forceinline__ bool next(int i, Unit& u) const {
        int L = i * G + c; const size_t tstep = (size_t)BM * K * 2;
        const int n0 = nM0 * nN0, n1 = nM1 * nN1, n2 = nM2 * nN2;
        if (L < n0) { tile_of(L, nM0, nN0, u.pm, u.pn); u.A = (const char*)A0 + u.pm * tstep; u.B = (const char*)B0 + u.pn * tstep; u.aux = 0; return true; }
        L -= n0;
        if (L < n1) { tile_of(L, nM1, nN1, u.pm, u.pn); u.A = (const char*)A1 + u.pm * tstep; u.B = (const char*)B1 + u.pn * tstep; u.aux = 1; return true; }
        L -= n1;
        if (L < n2) { tile_of(L, nM2, nN2, u.pm, u.pn); u.A = (const char*)A2 + u.pm * tstep; u.B = (const char*)B2 + u.pn * tstep; u.aux = 2; return true; }
        return false;
    }
};
struct SchedMerge {
    const unsigned char* ws; size_t h2g_off; int G, c;
    __device__ __forceinline__ bool next(int i, Unit& u) const {
        const int tile = (i / 6) * G + c; if (tile >= (TG / 256) * 4) return false;
        const int sub = i % 6, b = sub >> 1, kind = sub & 1; const size_t tstep = (size_t)BM * 1024 * 2;
        u.pm = tile >> 2; u.pn = tile & 3; u.aux = sub;
        const size_t yoff = (size_t)(b == 0) * O_LAU + (size_t)(b == 1) * O_ZX + (size_t)(b == 2) * O_ZMQ;
        const size_t aoff = (size_t)(kind == 0) * h2g_off + (size_t)(kind != 0) * yoff;
        const size_t woff = (size_t)(kind == 0) * O_WGATE + (size_t)(kind != 0) * O_WBR;
        u.A = (const char*)ws + aoff + u.pm * tstep; u.B = (const char*)ws + woff + (size_t)(b * 4 + u.pn) * tstep; return true;
    }
};

template <class Epi, class Sched>
__device__ __forceinline__ void gemm_phase(LAS unsigned char* lds, const int K, const Sched& S, const Epi& E) {
    const int tid = opaque_tid(), wid = __builtin_amdgcn_readfirstlane(tid >> 6), lane = tid & 63, wr = wid >> 2, wc = wid & 3, fr = lane & 15, fq = lane >> 4;
    const int nt = K / BK;
    unsigned voffA[2], voffB[2];
#pragma unroll
    for (int i = 0; i < 2; ++i) { int R, C; stage_rc(tid * 16 + i * 8192, R, C); const int Rb = Epi::PERM ? ((R & ~31) + perm32(R & 31)) : R;
        voffA[i] = (unsigned)(R * K + C) * 2u; voffB[i] = (unsigned)(Rb * K + C) * 2u; }
    const size_t kstep = (size_t)(BK * 2);
    const size_t hstep = (size_t)HALF * K * 2;
    const unsigned ldsw = (unsigned)wid * 1024u;
    const int aoff = lds_byte(wr * 64 + fr, fq * 8), boff = lds_byte(wc * 32 + fr, fq * 8);
#define PG8_SA(b, h) (((b) * 2 + (h)) * HTB)
#define PG8_SB(b, h) ((4 + (b) * 2 + (h)) * HTB)
#define PG8_STAGE(bufoff, gbase, voff) do { _Pragma("unroll") for (int _i = 0; _i < 2; ++_i) \
        __builtin_amdgcn_global_load_lds((const unsigned*)((const char*)(gbase) + (voff)[_i]), (LAS unsigned*)(lds + (bufoff) + ldsw + _i * 8192), 16, 0, 0); } while (0)
#define PG8_LDA(dst, b, h) do { _Pragma("unroll") for (int m = 0; m < 4; ++m) _Pragma("unroll") for (int k = 0; k < 2; ++k) dst[m][k] = *(const LAS bf16x8*)(lds + PG8_SA(b, h) + aoff + m * 2048 + k * 1024); } while (0)
#define PG8_LDB(dst, b, h) do { _Pragma("unroll") for (int n = 0; n < 2; ++n) _Pragma("unroll") for (int k = 0; k < 2; ++k) dst[n][k] = *(const LAS bf16x8*)(lds + PG8_SB(b, h) + boff + n * 2048 + k * 1024); } while (0)
#define PG8_MMA(ai, bj, At, Bt) do { __builtin_amdgcn_s_setprio(1); _Pragma("unroll") for (int m = 0; m < 4; ++m) _Pragma("unroll") for (int n = 0; n < 2; ++n) _Pragma("unroll") for (int k = 0; k < 2; ++k) \
        acc[ai][bj][m][n] = __builtin_amdgcn_mfma_f32_16x16x32_bf16(Bt[n][k], At[m][k], acc[ai][bj][m][n], 0, 0, 0); __builtin_amdgcn_s_setprio(0); } while (0)
#define PG8_WAIT_V(n) asm volatile("s_waitcnt vmcnt(" #n ")" ::: "memory")
#define PG8_WAIT_L(n) asm volatile("s_waitcnt lgkmcnt(" #n ")" ::: "memory")
#define PG8_BAR __builtin_amdgcn_s_barrier()
#define PG8_SCHED __builtin_amdgcn_sched_barrier(0)
    Unit cur, nxt; int ui = 0;
    if (!S.next(0, cur)) return;
    f32x4 acc[2][2][4][2];
#pragma unroll
    for (int a = 0; a < 2; ++a)
#pragma unroll
        for (int b = 0; b < 2; ++b)
#pragma unroll
            for (int m = 0; m < 4; ++m)
#pragma unroll
                for (int n = 0; n < 2; ++n) acc[a][b][m][n] = (f32x4){0.f, 0.f, 0.f, 0.f};
    bf16x8 At[4][2], B0[2][2], B1[2][2];
    const char* cA = cur.A; const char* cB = cur.B;
    PG8_STAGE(PG8_SB(0, 0), cB, voffB); PG8_STAGE(PG8_SA(0, 0), cA, voffA); PG8_STAGE(PG8_SB(0, 1), cB + hstep, voffB); PG8_STAGE(PG8_SA(0, 1), cA + hstep, voffA);
    if (wr == 1) PG8_BAR;
    PG8_WAIT_V(4); PG8_BAR;
    PG8_STAGE(PG8_SB(1, 0), cB + kstep, voffB); PG8_STAGE(PG8_SA(1, 0), cA + kstep, voffA); PG8_STAGE(PG8_SB(1, 1), cB + hstep + kstep, voffB);
    PG8_WAIT_V(6); PG8_BAR;
    for (;;) {
        const bool has_next = S.next(ui + 1, nxt);
        const char* nA = has_next ? nxt.A : cA; const char* nB = has_next ? nxt.B : cB;
        for (int t = 0; t < nt; t += 2) {
            const bool last = (t == nt - 2);
            const char* a1 = cA + (size_t)(t + 1) * kstep;
            const char* a2 = last ? nA : cA + (size_t)(t + 2) * kstep; const char* b2 = last ? nB : cB + (size_t)(t + 2) * kstep;
            const char* a3 = a2 + kstep; const char* b3 = b2 + kstep;
            PG8_LDB(B0, 0, 0); PG8_SCHED; PG8_LDA(At, 0, 0); PG8_STAGE(PG8_SA(1, 1), a1 + hstep, voffA);
            PG8_WAIT_L(8); PG8_BAR; PG8_WAIT_L(0); PG8_MMA(0, 0, At, B0); PG8_BAR; PG8_SCHED;
            PG8_LDB(B1, 0, 1); PG8_STAGE(PG8_SB(0, 0), b2, voffB);
            PG8_BAR; PG8_WAIT_L(0); PG8_MMA(0, 1, At, B1); PG8_BAR;
            PG8_LDA(At, 0, 1); PG8_STAGE(PG8_SA(0, 0), a2, voffA);
            PG8_BAR; PG8_WAIT_L(0); PG8_MMA(1, 0, At, B0); PG8_BAR; PG8_SCHED;
            PG8_STAGE(PG8_SB(0, 1), b2 + hstep, voffB);
            PG8_WAIT_V(6); PG8_BAR; PG8_MMA(1, 1, At, B1); PG8_BAR;
            PG8_LDB(B0, 1, 0); PG8_SCHED; PG8_LDA(At, 1, 0); PG8_STAGE(PG8_SA(0, 1), a2 + hstep, voffA);
            PG8_WAIT_L(8); PG8_BAR; PG8_WAIT_L(0); PG8_MMA(0, 0, At, B0); PG8_BAR; PG8_SCHED;
            PG8_LDB(B1, 1, 1); PG8_STAGE(PG8_SB(1, 0), b3, voffB);
            PG8_BAR; PG8_WAIT_L(0); PG8_MMA(0, 1, At, B1); PG8_BAR;
            PG8_LDA(At, 1, 1); PG8_STAGE(PG8_SA(1, 0), a3, voffA);
            PG8_BAR; PG8_WAIT_L(0); PG8_MMA(1, 0, At, B0); PG8_BAR; PG8_SCHED;
            PG8_STAGE(PG8_SB(1, 1), b3 + hstep, voffB);
            PG8_WAIT_V(6); PG8_BAR; PG8_MMA(1, 1, At, B1); PG8_BAR;
        }
        E(acc, cur, wr, wc, fr, fq);
        if (!has_next) break;
#pragma unroll
        for (int a = 0; a < 2; ++a)
#pragma unroll
            for (int b = 0; b < 2; ++b)
#pragma unroll
                for (int m = 0; m < 4; ++m)
#pragma unroll
                    for (int n = 0; n < 2; ++n) acc[a][b][m][n] = (f32x4){0.f, 0.f, 0.f, 0.f};
        cur = nxt; cA = nA; cB = nB; ++ui;
    }
    PG8_WAIT_V(0);
    if (wr == 0) PG8_BAR;
    PG8_BAR;
#undef PG8_SA
#undef PG8_SB
#undef PG8_STAGE
#undef PG8_LDA
#undef PG8_LDB
#undef PG8_MMA
#undef PG8_WAIT_V
#undef PG8_WAIT_L
#undef PG8_BAR
#undef PG8_SCHED
}

typedef f32x4 Acc[2][2][4][2];
template <int ACT>
__device__ __forceinline__ void store_bf16_tile(const Acc& acc, bf16_t* O, int ld, int rowbase, int colbase, int wr, int wc, int fr, int fq) {
    const int row0 = rowbase + wr * 64 + fr, col0 = colbase + wc * 32 + 8 * fq;
#pragma unroll
    for (int ai = 0; ai < 2; ++ai)
#pragma unroll
        for (int m = 0; m < 4; ++m) { bf16_t* rowp = O + (size_t)(row0 + ai * HALF + m * 16) * ld + col0;
#pragma unroll
            for (int bj = 0; bj < 2; ++bj) { f32x4 v0 = acc[ai][bj][m][0], v1 = acc[ai][bj][m][1];
                if (ACT == 1) {
#pragma unroll
                    for (int j = 0; j < 4; ++j) { v0[j] = gelu_tanh(v0[j]); v1[j] = gelu_tanh(v1[j]); } }
                u32x4 w; w.x = pk2(v0[0], v0[1]); w.y = pk2(v0[2], v0[3]); w.z = pk2(v1[0], v1[1]); w.w = pk2(v1[2], v1[3]);
                *(u32x4*)(rowp + bj * HALF) = w; } }
}
struct EpiFfnIn {
    static constexpr bool PERM = true;
    bf16_t* hid; bf16_t* memK; bf16_t* memVt;
    __device__ __forceinline__ void operator()(const Acc& acc, const Unit& u, int wr, int wc, int fr, int fq) const {
        if (u.aux == 0) {
            const int row0 = u.pm * BM + wr * 64 + fr, col0 = u.pn * HALF + wc * 32 + 8 * fq;
#pragma unroll
            for (int ai = 0; ai < 2; ++ai)
#pragma unroll
                for (int m = 0; m < 4; ++m) {
                    float o[8];
#pragma unroll
                    for (int n = 0; n < 2; ++n)
#pragma unroll
                        for (int j = 0; j < 4; ++j) { const float g = acc[ai][0][m][n][j], up = acc[ai][1][m][n][j]; o[n * 4 + j] = g * __builtin_amdgcn_rcpf(1.0f + __expf(-g)) * up; }
                    u32x4 w; w.x = pk2(o[0], o[1]); w.y = pk2(o[2], o[3]); w.z = pk2(o[4], o[5]); w.w = pk2(o[6], o[7]);
                    *(u32x4*)(hid + (size_t)(row0 + ai * HALF + m * 16) * FF + col0) = w; }
        } else if (u.aux == 1) store_bf16_tile<0>(acc, memK, 1024, u.pm * BM, u.pn * BM, wr, wc, fr, fq);
        else store_bf16_tile<0>(acc, memVt, TMEM, u.pm * BM, u.pn * BM, wr, wc, fr, fq);
    }
};
struct EpiResid {
    static constexpr bool PERM = false;
    const float* res; float* out; float scale;
    __device__ __forceinline__ void operator()(const Acc& acc, const Unit& u, int wr, int wc, int fr, int fq) const {
        const int row0 = u.pm * BM + wr * 64 + fr, col0 = u.pn * BM + wc * 32 + 4 * fq;
#pragma unroll
        for (int ai = 0; ai < 2; ++ai) {
            f32x4 r[4][2][2];
#pragma unroll
            for (int m = 0; m < 4; ++m) { const size_t off = (size_t)(row0 + ai * HALF + m * 16) * D + col0;
#pragma unroll
                for (int bj = 0; bj < 2; ++bj)
#pragma unroll
                    for (int n = 0; n < 2; ++n) r[m][bj][n] = *(const f32x4*)(res + off + bj * HALF + n * 16); }
            asm volatile("" ::: "memory");
#pragma unroll
            for (int m = 0; m < 4; ++m) { const size_t off = (size_t)(row0 + ai * HALF + m * 16) * D + col0;
#pragma unroll
                for (int bj = 0; bj < 2; ++bj)
#pragma unroll
                    for (int n = 0; n < 2; ++n) *(f32x4*)(out + off + bj * HALF + n * 16) = r[m][bj][n] + acc[ai][bj][m][n] * scale; }
            asm volatile("" ::: "memory");
        }
    }
};
struct EpiInProj {
    static constexpr bool PERM = true;
    bf16_t *zx, *zg, *zmq, *zl;
    __device__ __forceinline__ void operator()(const Acc& acc, const Unit& u, int wr, int wc, int fr, int fq) const {
        const int pn = u.pn;
        if (pn < 4) store_bf16_tile<0>(acc, zx, 1024, u.pm * BM, pn * BM, wr, wc, fr, fq);
        else if (pn < 8) store_bf16_tile<1>(acc, zg, 1024, u.pm * BM, (pn - 4) * BM, wr, wc, fr, fq);
        else if (pn < 12) store_bf16_tile<0>(acc, zmq, 1024, u.pm * BM, (pn - 8) * BM, wr, wc, fr, fq);
        else store_bf16_tile<0>(acc, zl, 768, u.pm * BM, (pn - 12) * BM, wr, wc, fr, fq);
    }
};
struct EpiPlain1 {
    static constexpr bool PERM = true;
    bf16_t* O; int ld;
    __device__ __forceinline__ void operator()(const Acc& acc, const Unit& u, int wr, int wc, int fr, int fq) const {
        store_bf16_tile<0>(acc, O, ld, u.pm * BM, u.pn * BM, wr, wc, fr, fq);
    }
};
struct EpiMerge {
    static constexpr bool PERM = true;
    bf16_t* gtmp; float* mrg; bf16_t* merged; const float* bgate;
    __device__ __forceinline__ void operator()(const Acc& acc, const Unit& u, int wr, int wc, int fr, int fq) const {
        const int b = u.aux >> 1, kind = u.aux & 1;
        const int row0 = u.pm * BM + wr * 64 + fr, col0 = u.pn * BM + wc * 32 + 8 * fq;
        if (kind == 0) {
#pragma unroll
            for (int bj = 0; bj < 2; ++bj) { const f32x4 b0 = *(const f32x4*)(bgate + b * D + col0 + bj * HALF), b1 = *(const f32x4*)(bgate + b * D + col0 + bj * HALF + 4);
#pragma unroll
                for (int ai = 0; ai < 2; ++ai)
#pragma unroll
                    for (int m = 0; m < 4; ++m) { f32x4 v0 = acc[ai][bj][m][0] + b0, v1 = acc[ai][bj][m][1] + b1;
#pragma unroll
                        for (int j = 0; j < 4; ++j) { v0[j] = sigmoidf_(v0[j]); v1[j] = sigmoidf_(v1[j]); }
                        u32x4 w; w.x = pk2(v0[0], v0[1]); w.y = pk2(v0[2], v0[3]); w.z = pk2(v1[0], v1[1]); w.w = pk2(v1[2], v1[3]);
                        *(u32x4*)(gtmp + (size_t)(row0 + ai * HALF + m * 16) * D + col0 + bj * HALF) = w; } }
        } else {
            bf16_t* mrgb = (bf16_t*)mrg;
#pragma unroll
            for (int ai = 0; ai < 2; ++ai) {
                u32x4 gq[4][2], mq[4][2];
#pragma unroll
                for (int m = 0; m < 4; ++m)
#pragma unroll
                    for (int bj = 0; bj < 2; ++bj) { const size_t off = (size_t)(row0 + ai * HALF + m * 16) * D + col0 + bj * HALF;
                        gq[m][bj] = *(const u32x4*)(gtmp + off);
                        mq[m][bj] = (u32x4){0u, 0u, 0u, 0u}; if (b > 0) mq[m][bj] = *(const u32x4*)(mrgb + off); }
                asm volatile("" ::: "memory");
#pragma unroll
                for (int m = 0; m < 4; ++m)
#pragma unroll
                    for (int bj = 0; bj < 2; ++bj) { const size_t off = (size_t)(row0 + ai * HALF + m * 16) * D + col0 + bj * HALF;
                        const u32x4 g = gq[m][bj], q = mq[m][bj];
                        f32x4 v0, v1; v0[0] = lo_f(g.x); v0[1] = hi_f(g.x); v0[2] = lo_f(g.y); v0[3] = hi_f(g.y); v1[0] = lo_f(g.z); v1[1] = hi_f(g.z); v1[2] = lo_f(g.w); v1[3] = hi_f(g.w);
                        f32x4 p0, p1; p0[0] = lo_f(q.x); p0[1] = hi_f(q.x); p0[2] = lo_f(q.y); p0[3] = hi_f(q.y); p1[0] = lo_f(q.z); p1[1] = hi_f(q.z); p1[2] = lo_f(q.w); p1[3] = hi_f(q.w);
                        v0 = v0 * acc[ai][bj][m][0] + p0; v1 = v1 * acc[ai][bj][m][1] + p1;
                        u32x4 w; w.x = pk2(v0[0], v0[1]); w.y = pk2(v0[2], v0[3]); w.z = pk2(v1[0], v1[1]); w.w = pk2(v1[2], v1[3]);
                        if (b < 2) *(u32x4*)(mrgb + off) = w; else *(u32x4*)(merged + off) = w; }
                asm volatile("" ::: "memory");
            }
        }
    }
};
}

__device__ __forceinline__ int wt_srccol(int map, int n0) {
    switch (map) {
        case 1: { const int pn = n0 >> 8, bj = (n0 >> 7) & 1, i = n0 & 127; return bj * FF + pn * 128 + i; }
        case 2: return n0 < 3072 ? 704 + n0 : (n0 < 3776 ? n0 - 3072 : -1);
        case 3: return 3776 + n0;
        case 4: return (n0 >> 7) * 256 + (n0 & 127);
        case 5: return (n0 >> 7) * 256 + 128 + (n0 & 127);
        case 6: return 1024 + n0;
        default: return n0;
    }
}
template <bool WEIGHTED>
__device__ __forceinline__ void wt_job(const float* __restrict__ src, int src_ld, bf16_t* __restrict__ dst, int K, int Np, int map, LAS unsigned char* lds, int G, int c) {
    const int tid = opaque_tid(), wid = tid >> 6, lane = tid & 63, kg = lane >> 3, ng = lane & 7; const int tk_n = K / 64, tn_n = Np / 32;
    const int hw = (G >> 1) * 8;
    const bool light = WEIGHTED && c < (G >> 1);
    const int w0 = WEIGHTED ? (light ? c * 8 + wid : (c - (G >> 1)) * 8 + wid) : c * 8 + wid;
    for (int u = w0; ; u += (WEIGHTED ? hw : G * 8)) {
        const int t = !WEIGHTED ? u : (light ? (u >> 1) * 10 + 8 + (u & 1) : (u >> 3) * 10 + (u & 7));
        if (t >= tk_n * tn_n) break;
        const int tn = t / tk_n, tk = t % tk_n, n0 = tn * 32, k0 = tk * 64; const int sc = wt_srccol(map, n0);
        f32x4 v[8];
#pragma unroll
        for (int j = 0; j < 8; ++j) { v[j] = (f32x4){0.f, 0.f, 0.f, 0.f}; if (sc >= 0) v[j] = *(const f32x4*)(src + (size_t)(k0 + kg * 8 + j) * src_ld + sc + ng * 4); }
#pragma unroll
        for (int i = 0; i < 4; ++i) { u32x4 w; w.x = pk2(v[0][i], v[1][i]); w.y = pk2(v[2][i], v[3][i]); w.z = pk2(v[4][i], v[5][i]); w.w = pk2(v[6][i], v[7][i]);
            *(u32x4*)(dst + (size_t)(n0 + ng * 4 + i) * K + k0 + kg * 8) = w; }
    }
}
constexpr int NR = 8;
__device__ __forceinline__ void rmsnorm_rows_bf16(const float* __restrict__ X, const float* __restrict__ g, bf16_t* __restrict__ out, int nrows, int G, int c) {
    const int tid_ = opaque_tid(); const int wid = tid_ >> 6, lane = tid_ & 63;
    f32x4 gv[4];
#pragma unroll
    for (int i = 0; i < 4; ++i) gv[i] = ((const f32x4*)g)[lane + 64 * i];
    for (int r = (c * 8 + wid) * NR; r < nrows; r += G * 8 * NR) {
        f32x4 v[NR][4]; float ss[NR]; _Pragma("unroll") for (int q = 0; q < NR; ++q) ss[q] = 0.f;
#pragma unroll
        for (int q = 0; q < NR; ++q)
#pragma unroll
            for (int i = 0; i < 4; ++i) v[q][i] = ((const f32x4*)(X + (size_t)(r + q) * D))[lane + 64 * i];
#pragma unroll
        for (int q = 0; q < NR; ++q) {
#pragma unroll
            for (int i = 0; i < 4; ++i) ss[q] += v[q][i][0] * v[q][i][0] + v[q][i][1] * v[q][i][1] + v[q][i][2] * v[q][i][2] + v[q][i][3] * v[q][i][3];
            ss[q] = wave_sum(ss[q]); const float rstd = rsqrtf(ss[q] * (1.0f / D) + 1e-6f);
#pragma unroll
            for (int i = 0; i < 4; ++i) { u32x2 w; w.x = pk2(v[q][i][0] * rstd * gv[i][0], v[q][i][1] * rstd * gv[i][1]); w.y = pk2(v[q][i][2] * rstd * gv[i][2], v[q][i][3] * rstd * gv[i][3]);
                *(u32x2*)(out + (size_t)(r + q) * D + (lane + 64 * i) * 4) = w; }
        }
    }
}
__device__ __forceinline__ void rmsnorm_rows_f32_inplace(float* X, const float* __restrict__ g, int nrows, int G, int c) {
    const int tid_ = opaque_tid(); const int wid = tid_ >> 6, lane = tid_ & 63;
    f32x4 gv[4];
#pragma unroll
    for (int i = 0; i < 4; ++i) gv[i] = ((const f32x4*)g)[lane + 64 * i];
    for (int r = (c * 8 + wid) * NR; r < nrows; r += G * 8 * NR) {
        f32x4 v[NR][4]; float ss[NR]; _Pragma("unroll") for (int q = 0; q < NR; ++q) ss[q] = 0.f;
#pragma unroll
        for (int q = 0; q < NR; ++q)
#pragma unroll
            for (int i = 0; i < 4; ++i) v[q][i] = ((const f32x4*)(X + (size_t)(r + q) * D))[lane + 64 * i];
        asm volatile("" ::: "memory");
#pragma unroll
        for (int q = 0; q < NR; ++q) {
#pragma unroll
            for (int i = 0; i < 4; ++i) ss[q] += v[q][i][0] * v[q][i][0] + v[q][i][1] * v[q][i][1] + v[q][i][2] * v[q][i][2] + v[q][i][3] * v[q][i][3];
            ss[q] = wave_sum(ss[q]); const float rstd = rsqrtf(ss[q] * (1.0f / D) + 1e-6f);
#pragma unroll
            for (int i = 0; i < 4; ++i) ((f32x4*)(X + (size_t)(r + q) * D))[lane + 64 * i] = v[q][i] * rstd * gv[i];
        }
    }
}
__device__ __forceinline__ void latent_rows(const bf16_t* __restrict__ zl, const float* __restrict__ qn, const float* __restrict__ kvn, const f32x2* __restrict__ rope, bf16_t* __restrict__ cqn, bf16_t* __restrict__ ckvn, bf16_t* __restrict__ krope, int G, int c) {
    const int tid_ = opaque_tid(); const int wid = tid_ >> 6, lane = tid_ & 63;
    for (int r = c * 8 + wid; r < TG; r += G * 8) {
        const bf16_t* zp = zl + (size_t)r * 768;
        float a[6]; float ss = 0.f;
        unsigned wq[3];
#pragma unroll
        for (int i = 0; i < 3; ++i) wq[i] = *(const unsigned*)(zp + lane * 2 + 128 * i);
        const u32x2 w2 = *(const u32x2*)(zp + 384 + lane * 4); const float v = bf2f(zp[640 + lane]);
        const f32x2 cs = rope[(r & (SEQ - 1)) * 32 + (lane & 31)];
#pragma unroll
        for (int i = 0; i < 3; ++i) { const unsigned w = wq[i]; a[2 * i] = lo_f(w); a[2 * i + 1] = hi_f(w); ss += a[2 * i] * a[2 * i] + a[2 * i + 1] * a[2 * i + 1]; }
        ss = wave_sum(ss); const float rq = rsqrtf(ss * (1.0f / 384.0f) + 1e-6f);
#pragma unroll
        for (int i = 0; i < 3; ++i) { const int col = lane * 2 + 128 * i; *(unsigned*)(cqn + (size_t)r * 384 + col) = pk2(a[2 * i] * rq * qn[col], a[2 * i + 1] * rq * qn[col + 1]); }
        float k4[4] = {lo_f(w2.x), hi_f(w2.x), lo_f(w2.y), hi_f(w2.y)};
        float s2 = k4[0] * k4[0] + k4[1] * k4[1] + k4[2] * k4[2] + k4[3] * k4[3]; s2 = wave_sum(s2); const float rk = rsqrtf(s2 * (1.0f / 256.0f) + 1e-6f);
        { const int col = lane * 4; u32x2 o; o.x = pk2(k4[0] * rk * kvn[col], k4[1] * rk * kvn[col + 1]); o.y = pk2(k4[2] * rk * kvn[col + 2], k4[3] * rk * kvn[col + 3]); *(u32x2*)(ckvn + (size_t)r * 256 + col) = o; }
        const float pv = __shfl_xor(v, 32);
        const float o = lane < 32 ? v * cs.x - pv * cs.y : v * cs.x + pv * cs.y;
        krope[(size_t)r * 64 + lane] = f2bf(o);
    }
}

__device__ __forceinline__ void rglru_tile(LAS unsigned char* lds, const Params& p, const bf16_t* zx, unsigned* lau, f32x2* summ, int gb, int tc, int n) {
    const int tid = opaque_tid(), wid = tid >> 6, lane = tid & 63, l15 = lane & 15, quad = lane >> 4;
    const bf16_t* WA = (const bf16_t*)(p.ws + O_WRGA) + (size_t)n * 128 * 128; const bf16_t* WI = (const bf16_t*)(p.ws + O_WRGI) + (size_t)n * 128 * 128;
    LAS unsigned char* xcs = lds;
    LAS unsigned* laus = (LAS unsigned*)(lds + 34816);
    LAS f32x2* segs = (LAS f32x2*)(lds + 34816 + 65536);
    const size_t tok0 = (size_t)gb * SEQ + tc * 128;
    const int e = wid * 16 + l15;
    bf16x8 fa[4], fi[4];
#pragma unroll
    for (int ks = 0; ks < 4; ++ks) { fa[ks] = *(const bf16x8*)(WA + (size_t)e * 128 + ks * 32 + quad * 8); fi[ks] = *(const bf16x8*)(WI + (size_t)e * 128 + ks * 32 + quad * 8); }
    const float bav = p.in[15][n * 128 + e], biv = p.in[17][n * 128 + e]; const float sp8 = -8.0f * log1pf(__expf(-p.in[18][n * 128 + e]));
    {
        const int cg8 = tid & 15, tg = tid >> 4, ch0 = n * 128 + cg8 * 8, t0 = tg * 4;
        float xin[7][8];
#pragma unroll
        for (int k = 0; k < 7; ++k) { const int t = t0 - 3 + k; u32x4 w = (u32x4){0u, 0u, 0u, 0u};
            if (tc * 128 + t >= 0) w = *(const u32x4*)(zx + (tok0 + t) * 1024 + ch0);
            xin[k][0] = lo_f(w.x); xin[k][1] = hi_f(w.x); xin[k][2] = lo_f(w.y); xin[k][3] = hi_f(w.y); xin[k][4] = lo_f(w.z); xin[k][5] = hi_f(w.z); xin[k][6] = lo_f(w.w); xin[k][7] = hi_f(w.w); }
        const float* cw = p.in[12]; const float* cb = p.in[13];
        float w0[8], w1[8], w2[8], w3[8], bb[8];
#pragma unroll
        for (int j = 0; j < 8; ++j) { w0[j] = cw[ch0 + j]; w1[j] = cw[1024 + ch0 + j]; w2[j] = cw[2048 + ch0 + j]; w3[j] = cw[3072 + ch0 + j]; bb[j] = cb[ch0 + j]; }
#pragma unroll
        for (int tt = 0; tt < 4; ++tt) { float o[8];
#pragma unroll
            for (int j = 0; j < 8; ++j) o[j] = w0[j] * xin[tt][j] + w1[j] * xin[tt + 1][j] + w2[j] * xin[tt + 2][j] + w3[j] * xin[tt + 3][j] + bb[j];
            u32x4 w; w.x = pk2(o[0], o[1]); w.y = pk2(o[2], o[3]); w.z = pk2(o[4], o[5]); w.w = pk2(o[6], o[7]);
            *(LAS u32x4*)(xcs + (t0 + tt) * 272 + cg8 * 16) = w; }
    }
    __syncthreads();
    {
#pragma unroll 2
        for (int tt = 0; tt < 8; ++tt) {
            f32x4 aa = (f32x4){0.f, 0.f, 0.f, 0.f}, ai = (f32x4){0.f, 0.f, 0.f, 0.f};
#pragma unroll
            for (int ks = 0; ks < 4; ++ks) { const bf16x8 af = *(const LAS bf16x8*)(xcs + (tt * 16 + l15) * 272 + ks * 64 + quad * 16);
                aa = __builtin_amdgcn_mfma_f32_16x16x32_bf16(af, fa[ks], aa, 0, 0, 0);
                ai = __builtin_amdgcn_mfma_f32_16x16x32_bf16(af, fi[ks], ai, 0, 0, 0); }
#pragma unroll
            for (int j = 0; j < 4; ++j) { const int t = tt * 16 + quad * 4 + j;
                const float r = sigmoidf_(aa[j] + bav), ig = sigmoidf_(ai[j] + biv);
                const float la = r * sp8; const float x2 = 2.0f * la;
                const float ser = -x2 * (1.0f + x2 * (0.5f + x2 * (0.16666667f + x2 * (0.041666667f + x2 * (0.0083333333f + x2 * 0.0013888889f)))));
                const float em = x2 > -0.3f ? ser : 1.0f - __expf(x2);
                const float xcv = bf2f(*(const LAS bf16_t*)(xcs + t * 272 + e * 2));
                const float uu = sqrtf(em) * ig * xcv;
                laus[t * 128 + e] = pk2(la, uu); }
        }
    }
    __syncthreads();
    {
        const int ch = tid & 127, seg = tid >> 7; float P = 1.f, H = 0.f;
#pragma unroll 4
        for (int t = seg * 32; t < seg * 32 + 32; ++t) { const unsigned w = laus[t * 128 + ch]; const float a = __expf(lo_f(w)); P *= a; H = a * H + hi_f(w); }
        segs[seg * 128 + ch] = (f32x2){P, H};
#pragma unroll
        for (int i = 0; i < 8; ++i) { const int id = i * 512 + tid, row = id >> 5, c4 = id & 31;
            *(u32x4*)(lau + (tok0 + row) * 1024 + n * 128 + c4 * 4) = *(const LAS u32x4*)(laus + row * 128 + c4 * 4); }
    }
    __syncthreads();
    if (tid < 128) { f32x2 s0 = segs[tid]; float P = s0.x, H = s0.y;
#pragma unroll
        for (int s = 1; s < 4; ++s) { const f32x2 sv = segs[s * 128 + tid]; H = sv.x * H + sv.y; P *= sv.x; }
        summ[(size_t)(gb * 16 + tc) * 1024 + n * 128 + tid] = (f32x2){P, H}; }
    __syncthreads();
}
__device__ __forceinline__ void scan_apply(const unsigned* __restrict__ lau, const f32x2* __restrict__ summ, const bf16_t* __restrict__ zg, bf16_t* __restrict__ yb, int gb, int tc, int half) {
    const int ch = half * 512 + opaque_tid(); float h = 0.f;
    const size_t base = ((size_t)gb * SEQ + tc * 128) * 1024 + ch;
    unsigned wv[16]; bf16_t gv[16];
#pragma unroll
    for (int i = 0; i < 16; ++i) { wv[i] = lau[base + (size_t)i * 1024]; gv[i] = zg[base + (size_t)i * 1024]; }
    f32x2 sv[15];
#pragma unroll
    for (int k = 0; k < 15; ++k) { sv[k] = (f32x2){1.f, 0.f}; if (k < tc) sv[k] = summ[(size_t)(gb * 16 + k) * 1024 + ch]; }
#pragma unroll
    for (int k = 0; k < 15; ++k) h = sv[k].x * h + sv[k].y;
#pragma unroll 1
    for (int tb = 0; tb < 8; ++tb) {
        unsigned wn[16]; bf16_t gn[16];
        if (tb < 7) {
#pragma unroll
            for (int i = 0; i < 16; ++i) { wn[i] = lau[base + (size_t)((tb + 1) * 16 + i) * 1024]; gn[i] = zg[base + (size_t)((tb + 1) * 16 + i) * 1024]; } }
#pragma unroll
        for (int i = 0; i < 16; ++i) { const float a = __expf(lo_f(wv[i])); h = a * h + hi_f(wv[i]); yb[base + (size_t)(tb * 16 + i) * 1024] = f2bf(h * bf2f(gv[i])); }
#pragma unroll
        for (int i = 0; i < 16; ++i) { wv[i] = wn[i]; gv[i] = gn[i]; }
    }
}

template <int DQK, int DV, int QT, int DK1, bool ROPE>
__device__ __forceinline__ void attn_item(LAS unsigned char* lds, const bf16_t* Q, int ldq, const bf16_t* K1, int ldk1, const bf16_t* K2, int ldk2,
                                          const bf16_t* Vt, int ldvt, bf16_t* O, int ldo, int ntiles, int wave_tiles, float c_scale, const f32x2* rope, int pos0) {
    constexpr int KSTR = DQK * 2 + 32, VSTR = 160, KBYTES = 64 * KSTR, BUF = KBYTES + DV * VSTR;
    static_assert(2 * BUF <= LDS_MAIN, "attention LDS");
    constexpr int NKS = DQK / 32, NDT = DV / 16, KCH = DQK / 8;
    constexpr int NKL = 64 * KCH / 512, NVL = DV * 8 / 512;
    const int tid = opaque_tid(), wid = tid >> 6, lane = tid & 63, l15 = lane & 15, quad = lane >> 4;
    const int wrow0 = wid * QT * 16;
    bf16x8 qf[QT][NKS];
#pragma unroll
    for (int qt = 0; qt < QT; ++qt) {
        const bf16_t* qp = Q + (size_t)(wrow0 + qt * 16 + l15) * ldq + quad * 8;
#pragma unroll
        for (int ks = 0; ks < NKS; ++ks) qf[qt][ks] = *(const bf16x8*)(qp + ks * 32);
        if (ROPE) {
            const f32x2* rp = rope + (size_t)(pos0 + wrow0 + qt * 16 + l15) * 32 + quad * 8;
            bf16x8 x1 = qf[qt][NKS - 2], x2 = qf[qt][NKS - 1];
#pragma unroll
            for (int e = 0; e < 8; ++e) { const f32x2 cs = rp[e]; const float a = bf2f((bf16_t)x1[e]), b = bf2f((bf16_t)x2[e]);
                x1[e] = (short)f2bf((a * cs.x - b * cs.y) * c_scale); x2[e] = (short)f2bf((b * cs.x + a * cs.y) * c_scale); }
            qf[qt][NKS - 2] = x1; qf[qt][NKS - 1] = x2;
        }
#pragma unroll
        for (int ks = 0; ks < (ROPE ? NKS - 2 : NKS); ++ks) { bf16x8 x = qf[qt][ks];
#pragma unroll
            for (int e = 0; e < 8; ++e) x[e] = (short)f2bf(bf2f((bf16_t)x[e]) * c_scale);
            qf[qt][ks] = x; }
    }
    f32x4 o[NDT][QT];
#pragma unroll
    for (int dt = 0; dt < NDT; ++dt)
#pragma unroll
        for (int qt = 0; qt < QT; ++qt) o[dt][qt] = (f32x4){0.f, 0.f, 0.f, 0.f};
    float mrow[QT], lrow[QT];
#pragma unroll
    for (int qt = 0; qt < QT; ++qt) { mrow[qt] = -1e30f; lrow[qt] = 0.f; }

    constexpr int C1 = DK1 / 8, C2 = (DQK - DK1) / 8, NK1 = 64 * C1 / 512, NK2 = 64 * C2 / 512;
    static_assert(NK1 * 512 == 64 * C1 && NK2 * 512 == 64 * C2 && NK1 + NK2 == NKL, "chunking");
    u32x4 kst1[NK1], kst2[NK2 ? NK2 : 1], vst[NVL];
    unsigned k1o[NK1], k2o[NK2 ? NK2 : 1], vo[NVL];
#pragma unroll
    for (int i = 0; i < NK1; ++i) { const int ci = tid + 512 * i; k1o[i] = (unsigned)((ci / C1) * ldk1 + (ci % C1) * 8); }
#pragma unroll
    for (int i = 0; i < NK2; ++i) { const int ci = tid + 512 * i; k2o[i] = (unsigned)((ci / (C2 ? C2 : 1)) * ldk2 + (ci % (C2 ? C2 : 1)) * 8); }
#pragma unroll
    for (int i = 0; i < NVL; ++i) { const int ci = tid + 512 * i; vo[i] = (unsigned)((ci >> 3) * ldvt + (ci & 7) * 8); }
#define ATT_LOAD(j) do { const bf16_t* k1p = K1 + (size_t)(j) * 64 * ldk1; const bf16_t* k2p = K2 + (size_t)(j) * 64 * ldk2; const bf16_t* vp_ = Vt + (size_t)(j) * 64; \
        _Pragma("unroll") for (int i = 0; i < NK1; ++i) kst1[i] = *(const u32x4*)(k1p + k1o[i]); \
        _Pragma("unroll") for (int i = 0; i < NK2; ++i) kst2[i] = *(const u32x4*)(k2p + k2o[i]); \
        _Pragma("unroll") for (int i = 0; i < NVL; ++i) vst[i] = *(const u32x4*)(vp_ + vo[i]); } while (0)
#define KSLOT(k) ((((k) >> 5) * 2 + (((k) >> 2) & 1)) * 16 + (((k) >> 3) & 3) * 4 + ((k) & 3))
#define ATT_WRITE(b) do { LAS unsigned char* kb_ = lds + (b) * BUF; \
        _Pragma("unroll") for (int i = 0; i < NK1; ++i) { const int ci = tid + 512 * i; *(LAS u32x4*)(kb_ + KSLOT(ci / C1) * KSTR + (ci % C1) * 16) = kst1[i]; } \
        _Pragma("unroll") for (int i = 0; i < NK2; ++i) { const int ci = tid + 512 * i; *(LAS u32x4*)(kb_ + KSLOT(ci / (C2 ? C2 : 1)) * KSTR + DK1 * 2 + (ci % (C2 ? C2 : 1)) * 16) = kst2[i]; } \
        _Pragma("unroll") for (int i = 0; i < NVL; ++i) { const int ci = tid + 512 * i; *(LAS u32x4*)(kb_ + KBYTES + (ci >> 3) * VSTR + (ci & 7) * 16) = vst[i]; } } while (0)
    ATT_LOAD(0); ATT_WRITE(0);
    __syncthreads();
    for (int j = 0; j < ntiles; ++j) {
        const bool more = (j + 1 < ntiles);
        if (more) ATT_LOAD(j + 1);
        __builtin_amdgcn_sched_barrier(0);
        if (j < wave_tiles) {
            const LAS unsigned char* kb = lds + (j & 1) * BUF; const LAS unsigned char* vb = kb + KBYTES;
            f32x4 s[4][QT];
#pragma unroll
            for (int kt = 0; kt < 4; ++kt)
#pragma unroll
                for (int qt = 0; qt < QT; ++qt) s[kt][qt] = (f32x4){0.f, 0.f, 0.f, 0.f};
            {
                bf16x8 kf[2][4];
#pragma unroll
                for (int kt = 0; kt < 4; ++kt) kf[0][kt] = *(const LAS bf16x8*)(kb + (kt * 16 + l15) * KSTR + quad * 16);
#pragma unroll
                for (int ks = 0; ks < NKS; ++ks) {
                    if (ks + 1 < NKS) {
#pragma unroll
                        for (int kt = 0; kt < 4; ++kt) kf[(ks + 1) & 1][kt] = *(const LAS bf16x8*)(kb + (kt * 16 + l15) * KSTR + (ks + 1) * 64 + quad * 16); }
#pragma unroll
                    for (int kt = 0; kt < 4; ++kt)
#pragma unroll
                        for (int qt = 0; qt < QT; ++qt) s[kt][qt] = __builtin_amdgcn_mfma_f32_16x16x32_bf16(kf[ks & 1][kt], qf[qt][ks], s[kt][qt], 0, 0, 0);
                    __builtin_amdgcn_sched_barrier(0);
                }
            }
            bf16x8 pf[QT][2];
#pragma unroll
            for (int qt = 0; qt < QT; ++qt) {
                float mx = -1e30f;
#pragma unroll
                for (int kt = 0; kt < 4; ++kt)
#pragma unroll
                    for (int jj = 0; jj < 4; ++jj) mx = fmaxf(mx, s[kt][qt][jj]);
                if (__builtin_amdgcn_ballot_w64(mx > mrow[qt] + 8.0f) != 0ull) {
                    mx = fmaxf(mx, __shfl_xor(mx, 16)); mx = fmaxf(mx, __shfl_xor(mx, 32));
                    const float mnew = fmaxf(mrow[qt], mx); const float alpha = __builtin_amdgcn_exp2f(mrow[qt] - mnew); mrow[qt] = mnew; lrow[qt] *= alpha;
#pragma unroll
                    for (int dt = 0; dt < NDT; ++dt) o[dt][qt] = o[dt][qt] * alpha; }
                const float mcur = mrow[qt];
                float ps = 0.f;
#pragma unroll
                for (int kt = 0; kt < 4; ++kt)
#pragma unroll
                    for (int jj = 0; jj < 4; ++jj) { const float pv = __builtin_amdgcn_exp2f(s[kt][qt][jj] - mcur); s[kt][qt][jj] = pv; ps += pv; }
                lrow[qt] += ps;
#pragma unroll
                for (int s2 = 0; s2 < 2; ++s2) { u32x4 w; w.x = pk2(s[2 * s2][qt][0], s[2 * s2][qt][1]); w.y = pk2(s[2 * s2][qt][2], s[2 * s2][qt][3]);
                    w.z = pk2(s[2 * s2 + 1][qt][0], s[2 * s2 + 1][qt][1]); w.w = pk2(s[2 * s2 + 1][qt][2], s[2 * s2 + 1][qt][3]); pf[qt][s2] = __builtin_bit_cast(bf16x8, w); }
            }
            {
                constexpr int NST = 2 * (NDT / 4);
                bf16x8 vf[2][4];
#define ATT_VLOAD(buf, st) do { const int s2_ = (st) / (NDT / 4), dg_ = (st) % (NDT / 4); _Pragma("unroll") for (int d4 = 0; d4 < 4; ++d4) \
                    vf[buf][d4] = *(const LAS bf16x8*)(vb + ((dg_ * 4 + d4) * 16 + l15) * VSTR + s2_ * 64 + quad * 16); } while (0)
                ATT_VLOAD(0, 0);
#pragma unroll
                for (int st = 0; st < NST; ++st) {
                    if (st + 1 < NST) ATT_VLOAD((st + 1) & 1, st + 1);
                    const int s2 = st / (NDT / 4), dg = st % (NDT / 4);
#pragma unroll
                    for (int d4 = 0; d4 < 4; ++d4)
#pragma unroll
                        for (int qt = 0; qt < QT; ++qt) o[dg * 4 + d4][qt] = __builtin_amdgcn_mfma_f32_16x16x32_bf16(vf[st & 1][d4], pf[qt][s2], o[dg * 4 + d4][qt], 0, 0, 0);
                    __builtin_amdgcn_sched_barrier(0);
                }
#undef ATT_VLOAD
            }
        }
        if (more) ATT_WRITE((j + 1) & 1);
        __syncthreads();
    }
#undef ATT_LOAD
#undef ATT_WRITE
#undef KSLOT
#pragma unroll
    for (int qt = 0; qt < QT; ++qt) {
        float l = lrow[qt]; l += __shfl_xor(l, 16); l += __shfl_xor(l, 32); const float inv = 1.0f / l;
        bf16_t* op = O + (size_t)(wrow0 + qt * 16 + l15) * ldo + quad * 4;
#pragma unroll
        for (int dt = 0; dt < NDT; ++dt) { u32x2 w; w.x = pk2(o[dt][qt][0] * inv, o[dt][qt][1] * inv); w.y = pk2(o[dt][qt][2] * inv, o[dt][qt][3] * inv); *(u32x2*)(op + dt * 16) = w; }
    }
}


#define XB_TMO      128
#define XB_XCNT(j)  (256  + 64 * (j))
#define XB_XSUB(j)  (1280 + 64 * (j))
#define XB_XGEN(j)  (2304 + 64 * (j))
#define XB_TOP      3328
#define XB_TOPGEN   3392
#define XCD_BAR_WORDS 3456
#define XB_SPIN_CAP (1u << 22)
__device__ __forceinline__ unsigned xb_ld(unsigned* p)              { return __hip_atomic_load(p, __ATOMIC_RELAXED, __HIP_MEMORY_SCOPE_AGENT); }
__device__ __forceinline__ unsigned xb_add(unsigned* p, unsigned v) { return __hip_atomic_fetch_add(p, v, __ATOMIC_RELAXED, __HIP_MEMORY_SCOPE_AGENT); }
__device__ __forceinline__ unsigned xb_xcc_id() { return (unsigned)__builtin_amdgcn_s_getreg((3 << 11) | 20) & 0xFu; }
#define XB_SPIN(cond, bar) do { unsigned _sp = 0; while (cond) { __builtin_amdgcn_s_sleep(1); \
    if ((++_sp & 255u) == 0u) { if (xb_ld(&(bar)[XB_TMO])) break; if (_sp > XB_SPIN_CAP) { atomicAdd(&(bar)[XB_TMO], 1u); break; } } } } while (0)
struct XcdBarrier { unsigned* bar; unsigned x; volatile LAS unsigned* st; };
__device__ __forceinline__ XcdBarrier xcd_barrier_post(unsigned* bar, volatile LAS unsigned* st) {
    XcdBarrier b; b.bar = bar; b.x = xb_xcc_id(); b.st = st;
    if (threadIdx.x == 0) (void)xb_add(&bar[XB_XCNT(b.x)], 1u);
    return b;
}
__device__ __forceinline__ void xcd_barrier_complete(unsigned* bar, unsigned x, unsigned& nloc, unsigned& nx) {
    const unsigned G = gridDim.x * gridDim.y * gridDim.z;
    unsigned sum, cnt, mine, sp = 0u;
    for (;;) {
        sum = 0u; cnt = 0u; mine = 0u;
#pragma unroll
        for (unsigned j = 0; j < 16; ++j) { const unsigned c = xb_ld(&bar[XB_XCNT(j)]); sum += c; cnt += (c > 0u) ? 1u : 0u; mine = (j == x) ? c : mine; }
        if (sum == G) break;
        __builtin_amdgcn_s_sleep(1);
        if ((++sp & 255u) == 0u) { if (xb_ld(&bar[XB_TMO])) break; if (sp > XB_SPIN_CAP) { atomicAdd(&bar[XB_TMO], 1u); break; } }
    }
    nloc = mine > 0u ? mine : 1u; nx = cnt > 0u ? cnt : 1u;
}
__device__ __forceinline__ void xcd_barrier(const XcdBarrier& b) {
    asm volatile("s_waitcnt vmcnt(0)" ::: "memory");
    __syncthreads();
    if (threadIdx.x == 0) {
        unsigned* bar = b.bar;
        __builtin_amdgcn_s_waitcnt(0);
        unsigned nloc = b.st[0], nx = b.st[1];
        if (nloc == 0u) { xcd_barrier_complete(bar, b.x, nloc, nx); b.st[0] = nloc; b.st[1] = nx; }
        const unsigned old = xb_add(&bar[XB_XSUB(b.x)], 1u);
        const unsigned gen = old / nloc;
        if (old + 1u == (gen + 1u) * nloc) {
            __builtin_amdgcn_fence(__ATOMIC_RELEASE, "agent");
            asm volatile("s_waitcnt vmcnt(0)" ::: "memory");
            const unsigned og = xb_add(&bar[XB_TOP], 1u);
            const unsigned tg = og / nx;
            if (og + 1u == (tg + 1u) * nx) xb_add(&bar[XB_TOPGEN], 1u);
            else XB_SPIN(xb_ld(&bar[XB_TOPGEN]) == tg, bar);
            __builtin_amdgcn_fence(__ATOMIC_ACQUIRE, "agent");
            xb_add(&bar[XB_XGEN(b.x)], 1u);
            asm volatile("s_waitcnt vmcnt(0)" ::: "memory");
        } else {
            XB_SPIN(xb_ld(&bar[XB_XGEN(b.x)]) == gen, bar);
            __builtin_amdgcn_fence(__ATOMIC_ACQUIRE, "agent");
            asm volatile("s_waitcnt vmcnt(0)" ::: "memory");
        }
    }
    __syncthreads();
}

#define WT_JOBS(COND, WGT) \
_Pragma("unroll 1") \
        for (int job = 0; job < 31; ++job) { if (!(COND)) continue; \
            const float* src; int sld, K, Np, map; size_t doff; \
            if (job == 0)      { src = p.in[3];  sld = 5632; doff = O_W1IN;  K = 1024; Np = 5632; map = 1; } \
            else if (job == 1) { src = p.in[4];  sld = 1024; doff = O_W1DN;  K = 2816; Np = 1024; map = 0; } \
            else if (job == 2) { src = p.in[24]; sld = 5632; doff = O_W2IN;  K = 1024; Np = 5632; map = 1; } \
            else if (job == 3) { src = p.in[25]; sld = 1024; doff = O_W2DN;  K = 2816; Np = 1024; map = 0; } \
            else if (job == 4) { src = p.in[6];  sld = INW;  doff = O_WINA;  K = 1024; Np = 3840; map = 2; } \
            else if (job == 5) { src = p.in[6];  sld = INW;  doff = O_WGATE; K = 1024; Np = 3072; map = 3; } \
            else if (job == 6) { src = p.in[9];  sld = 1536; doff = O_WUQ;   K = 384;  Np = 1536; map = 0; } \
            else if (job == 7) { src = p.in[11]; sld = 2048; doff = O_WUK;   K = 256;  Np = 1024; map = 4; } \
            else if (job == 8) { src = p.in[11]; sld = 2048; doff = O_WUV;   K = 256;  Np = 1024; map = 5; } \
            else if (job == 9) { src = p.in[20]; sld = 2048; doff = O_WMK;   K = 1024; Np = 1024; map = 0; } \
            else if (job == 10) { src = p.in[20]; sld = 2048; doff = O_WMV;  K = 1024; Np = 1024; map = 6; } \
            else if (job < 14) { const int b = job - 11; src = p.in[21] + (size_t)b * D * D; sld = 1024; doff = O_WBR + (size_t)b * D * D * 2; K = 1024; Np = 1024; map = 0; } \
            else if (job == 14) { src = p.in[22]; sld = 1024; doff = O_WOUT; K = 1024; Np = 1024; map = 0; } \
            else if (job < 23) { const int n = job - 15; src = p.in[14] + n * 16384; sld = 128; doff = O_WRGA + (size_t)n * 32768; K = 128; Np = 128; map = 0; } \
            else { const int n = job - 23; src = p.in[16] + n * 16384; sld = 128; doff = O_WRGI + (size_t)n * 32768; K = 128; Np = 128; map = 0; } \
            wt_job<WGT>(src, sld, (bf16_t*)(ws + doff), K, Np, map, lds, G, c); \
        } \
        f32x2* rope = (f32x2*)(ws + O_ROPE); \

constexpr int N_PHASES = 20;
__global__ void __launch_bounds__(512, 2) mega(Params p) {
    extern __shared__ __attribute__((aligned(16))) unsigned char smem[];
    LAS unsigned char* lds = (LAS unsigned char*)smem;
    cg::grid_group grid = cg::this_grid();
    const int G = gridDim.x, c = blockIdx.x, tid = threadIdx.x;
    unsigned char* ws = p.ws;
#ifndef PH_MASK
#define PH_MASK 0xFFFFF
#endif
#ifndef REP_MASK
#define REP_MASK 0
#endif
#define REPS(k) for (int rep_ = 0; rep_ < (int)((REP_MASK >> (k)) & 1) + 1; ++rep_)
#define IN(k) (((PH_MASK >> (k)) & 1) && p.ph_lo <= (k) && (k) < p.ph_hi)
#define INM(j) (((PH_MASK >> (4 + (j))) & 1) && p.ph_lo <= (ph + (j)) && (ph + (j)) < p.ph_hi)
#define SEAM(k) do { if (p.ph_lo <= (k) && (k) + 1 < p.ph_hi) { xcd_barrier(xbar); } } while (0)
    bf16_t* Hb = (bf16_t*)(ws + O_H);
    if (tid < 4) ((LAS unsigned*)(lds + LDS_MAIN))[tid] = 0u;
    __syncthreads();
    XcdBarrier xbar = xcd_barrier_post((unsigned*)(ws + O_BAR), (volatile LAS unsigned*)(lds + LDS_MAIN));

    if (IN(0)) REPS(0) {
        WT_JOBS(job == 0 || job == 9 || job == 10, false);
        for (int i = c * 512 + tid; i < SEQ * 32; i += G * 512) { const int pos = i >> 5, fi = i & 31;
            const float inv = 1.0f / powf(10000.0f, (float)(2 * fi) / 64.0f); const float ang = (float)pos * inv; rope[i] = (f32x2){cosf(ang), sinf(ang)}; }
        rmsnorm_rows_bf16(p.in[1], p.in[19], (bf16_t*)(ws + O_MEMN), TMEM, G, c);
        rmsnorm_rows_bf16(p.in[0], p.in[2], Hb, T, G, c);
    }
    if (p.ph_lo < 0) grid.sync();
    SEAM(0);
    if (IN(1)) REPS(1) {
        pg8::Sched3 S{Hb, (const bf16_t*)(ws + O_W1IN), (const bf16_t*)(ws + O_MEMN), (const bf16_t*)(ws + O_WMK), (const bf16_t*)(ws + O_WMV), (const bf16_t*)(ws + O_MEMN),
                      T / 256, 22, TMEM / 256, 4, 4, TMEM / 256, G, c, 1024};
        pg8::EpiFfnIn E{(bf16_t*)(ws + O_HID), (bf16_t*)(ws + O_MEMK), (bf16_t*)(ws + O_MEMVT)};
        pg8::gemm_phase(lds, 1024, S, E);
        WT_JOBS(!(job == 0 || job == 9 || job == 10), true);
    }
    SEAM(1);
    if (IN(2)) REPS(2) {
        pg8::Sched3 S{(const bf16_t*)(ws + O_HID), (const bf16_t*)(ws + O_W1DN), nullptr, nullptr, nullptr, nullptr, T / 256, 4, 0, 0, 0, 0, G, c, FF};
        pg8::EpiResid E{p.in[0], p.out, 0.5f};
        pg8::gemm_phase(lds, FF, S, E);
    }
    SEAM(2);
    if (IN(3)) REPS(3) rmsnorm_rows_bf16(p.out, p.in[5], Hb, T, G, c);
    SEAM(3);
    bf16_t* zx = (bf16_t*)(ws + O_ZX); bf16_t* zg = (bf16_t*)(ws + O_ZG); bf16_t* zmq = (bf16_t*)(ws + O_ZMQ); bf16_t* zl = (bf16_t*)(ws + O_ZL);
    bf16_t* cqn = (bf16_t*)(ws + O_CQN); bf16_t* ckvn = (bf16_t*)(ws + O_CKVN); bf16_t* krope = (bf16_t*)(ws + O_KROPE);
    unsigned* lau = (unsigned*)(ws + O_LAU); f32x2* summ = (f32x2*)(ws + O_SUMM);
    bf16_t* qb = (bf16_t*)(ws + O_Q); bf16_t* knope = (bf16_t*)(ws + O_KNOPE); bf16_t* vt = (bf16_t*)(ws + O_VT);
    bf16_t* ya = (bf16_t*)(ws + O_LAU); bf16_t* yb = zx; bf16_t* yc = zmq;
    bf16_t* gtmp = zg; float* mrg = (float*)(ws + O_Q); bf16_t* merged = (bf16_t*)(ws + O_VT);
    const f32x2* rope = (const f32x2*)(ws + O_ROPE);
#pragma unroll 1
    for (int g = 0; g < NG; ++g) {
        const int ph = 4 + 6 * g;
        const bf16_t* h2g = Hb + (size_t)g * TG * D;
        if (INM(0)) REPS(4) {
            pg8::Sched3 S{h2g, (const bf16_t*)(ws + O_WINA), nullptr, nullptr, nullptr, nullptr, TG / 256, 15, 0, 0, 0, 0, G, c, 1024};
            pg8::EpiInProj E{zx, zg, zmq, zl};
            pg8::gemm_phase(lds, 1024, S, E);
        }
        SEAM(ph);
        if (INM(1)) REPS(5) {
            for (int it = c; it < GB * 16 * 8; it += G) { const int n = it & 7, tc = (it >> 3) & 15, gb = it >> 7; rglru_tile(lds, p, zx, lau, summ, gb, tc, n); }
            latent_rows(zl, p.in[8], p.in[10], rope, cqn, ckvn, krope, G, c);
        }
        SEAM(ph + 1);
        if (INM(2)) REPS(6) {
            { pg8::Sched3 S{cqn, (const bf16_t*)(ws + O_WUQ), nullptr, nullptr, nullptr, nullptr, TG / 256, 6, 0, 0, 0, 0, G, c, 384};
              pg8::EpiPlain1 E{qb, 1536}; pg8::gemm_phase(lds, 384, S, E); }
            { pg8::Sched3 S{ckvn, (const bf16_t*)(ws + O_WUK), nullptr, nullptr, nullptr, nullptr, TG / 256, 4, 0, 0, 0, 0, G, G - 1 - c, 256};
              pg8::EpiPlain1 E{knope, 1024}; pg8::gemm_phase(lds, 256, S, E); }
            const int Gv = (G == 256) ? 128 : G, cv = (G == 256) ? (c >= 128 ? c - 128 : (1 << 20)) : c;
            { pg8::Sched3 S{(const bf16_t*)(ws + O_WUV), ckvn, nullptr, nullptr, nullptr, nullptr, 4, TG / 256, 0, 0, 0, 0, Gv, cv, 256};
              pg8::EpiPlain1 E{vt, TG}; pg8::gemm_phase(lds, 256, S, E); }
            for (int it = c; it < GB * 16 * 2; it += G) { const int half = it & 1, tc = (it >> 1) & 15, gb = it >> 5; scan_apply(lau, summ, zg, yb, gb, tc, half); }
        }
        SEAM(ph + 2);
        if (INM(3)) {
#ifndef ATT_SEL
#define ATT_SEL 3
#endif
            if (ATT_SEL & 1) REPS(7) for (int pr0 = c; pr0 < GB * 8 * 4; pr0 += G) {
                const int pr = (G == 256) ? (((pr0 & 7) << 5) | (pr0 >> 3)) : pr0;
                const int qp = pr & 3, h = (pr >> 2) & 7, gb = pr >> 5;
#pragma unroll 1
                for (int w = 0; w < 2; ++w) { const int qblk = w == 0 ? 7 - qp : qp; const size_t tok0 = (size_t)gb * SEQ + qblk * 256;
                    attn_item<192, 128, 2, 128, true>(lds, qb + tok0 * 1536 + h * 192, 1536, knope + (size_t)gb * SEQ * 1024 + h * 128, 1024, krope + (size_t)gb * SEQ * 64, 64,
                        vt + (size_t)h * 128 * TG + (size_t)gb * SEQ, TG, ya + tok0 * 1024 + h * 128, 1024, 4 * qblk + 4, 4 * qblk + (tid >> 7) + 1,
                        0.07216878364870322f * 1.4426950408889634f, rope, qblk * 256); }
            }
            if (ATT_SEL & 2) for (int it = c; it < GB * 4 * 16; it += G) {
                const int qblk = it & 15, h = (it >> 4) & 3, gb = it >> 6; const int bglob = g * GB + gb; const size_t tok0 = (size_t)gb * SEQ + qblk * 128;
                attn_item<256, 256, 1, 256, false>(lds, zmq + tok0 * 1024 + h * 256, 1024, (const bf16_t*)(ws + O_MEMK) + (size_t)bglob * NMEM * 1024 + h * 256, 1024, nullptr, 0,
                    (const bf16_t*)(ws + O_MEMVT) + (size_t)h * 256 * TMEM + (size_t)bglob * NMEM, TMEM, yc + tok0 * 1024 + h * 256, 1024, 4, 4, 0.0625f * 1.4426950408889634f, rope, 0);
            }
        }
        SEAM(ph + 3);
        if (INM(4)) REPS(8) {
            pg8::SchedMerge S{ws, O_H + (size_t)g * TG * D * 2, G, c};
            pg8::EpiMerge E{gtmp, mrg, merged, p.in[7]};
            pg8::gemm_phase(lds, 1024, S, E);
        }
        SEAM(ph + 4);
        if (INM(5)) {
            pg8::Sched3 S{merged, (const bf16_t*)(ws + O_WOUT), nullptr, nullptr, nullptr, nullptr, TG / 256, 4, 0, 0, 0, 0, G, c, 1024};
            float* xo = p.out + (size_t)g * TG * D;
            pg8::EpiResid E{xo, xo, 1.0f};
            pg8::gemm_phase(lds, 1024, S, E);
        }
        if (g == NG - 1) SEAM(ph + 5);
    }
    if (IN(16)) REPS(16) rmsnorm_rows_bf16(p.out, p.in[23], Hb, T, G, c);
    SEAM(16);
    if (IN(17)) REPS(17) {
        pg8::Sched3 S{Hb, (const bf16_t*)(ws + O_W2IN), nullptr, nullptr, nullptr, nullptr, T / 256, 22, 0, 0, 0, 0, G, c, 1024};
        pg8::EpiFfnIn E{(bf16_t*)(ws + O_HID), nullptr, nullptr};
        pg8::gemm_phase(lds, 1024, S, E);
    }
    SEAM(17);
    if (IN(18)) {
        pg8::Sched3 S{(const bf16_t*)(ws + O_HID), (const bf16_t*)(ws + O_W2DN), nullptr, nullptr, nullptr, nullptr, T / 256, 4, 0, 0, 0, 0, G, c, FF};
        pg8::EpiResid E{p.out, p.out, 0.5f};
        pg8::gemm_phase(lds, FF, S, E);
    }
    SEAM(18);
    if (IN(19)) rmsnorm_rows_f32_inplace(p.out, p.in[26], T, G, c);
#undef IN
#undef INM
#undef SEAM
}

extern "C" void kernel_launch(void* const* d_in, const int* in_sizes, int n_in, void* d_out, int out_size, void* d_ws, size_t ws_size, hipStream_t stream) {
    static int grid = 0;
    if (grid == 0) {
        int dev = 0, cus = 0, per_cu = 0;
        hipGetDevice(&dev);
        hipDeviceGetAttribute(&cus, hipDeviceAttributeMultiprocessorCount, dev);
        hipFuncSetAttribute((const void*)mega, hipFuncAttributeMaxDynamicSharedMemorySize, LDS_BYTES);
        hipOccupancyMaxActiveBlocksPerMultiprocessor(&per_cu, (const void*)mega, 512, LDS_BYTES);
        if (per_cu < 1) { fprintf(stderr, "occupancy query returned %d\n", per_cu); per_cu = 1; }
        grid = cus * 1;
        if (ws_size < O_END) { fprintf(stderr, "workspace too small: %zu < %zu\n", ws_size, (size_t)O_END); grid = -1; }
    }
    if (grid < 0) return;
    Params p{};
    for (int i = 0; i < 27; ++i) p.in[i] = (const float*)d_in[i];
    p.out = (float*)d_out; p.ws = (unsigned char*)d_ws;
#if MK_ONE_LAUNCH
    p.ph_lo = 0; p.ph_hi = N_PHASES;
    (void)hipMemsetAsync((unsigned char*)d_ws + O_BAR, 0, XCD_BAR_WORDS * 4, stream);
    void* args[] = {&p};
    hipError_t e = hipLaunchCooperativeKernel((const void*)mega, dim3(grid), dim3(512), args, LDS_BYTES, stream);
    if (e != hipSuccess) fprintf(stderr, "cooperative launch failed: %s (grid %d)\n", hipGetErrorString(e), grid);
#else
    for (int k = 0; k < N_PHASES; ++k) { p.ph_lo = k; p.ph_hi = k + 1; hipLaunchKernelGGL(mega, dim3(grid), dim3(512), LDS_BYTES, stream, p); }
#endif
}
```

```cpp
#include <hip/hip_runtime.h>
#include <hip/hip_cooperative_groups.h>
#include <cstdio>
namespace cg = cooperative_groups;

#ifndef MK_ONE_LAUNCH
#define MK_ONE_LAUNCH 1
#endif

#define LAS __attribute__((address_space(3)))
typedef unsigned short bf16_t;
typedef short bf16x8 __attribute__((ext_vector_type(8)));
typedef short bf16x4 __attribute__((ext_vector_type(4)));
typedef float f32x4 __attribute__((ext_vector_type(4)));
typedef float f32x2 __attribute__((ext_vector_type(2)));
typedef unsigned u32x4 __attribute__((ext_vector_type(4)));
typedef unsigned u32x2 __attribute__((ext_vector_type(2)));

constexpr int D = 1024, T = 32768, SEQ = 2048, FF = 2816, NBATCH = 16;
constexpr int GB = 8, TG = GB * SEQ, NG = NBATCH / GB;
constexpr int NMEM = 256, TMEM = NBATCH * NMEM;
constexpr int INW = 6848;

constexpr size_t MiB = 1u << 20;
constexpr size_t O_W1IN = 0;
constexpr size_t O_W1DN = O_W1IN + (size_t)5632 * 1024 * 2;
constexpr size_t O_W2IN = O_W1DN + (size_t)1024 * 2816 * 2;
constexpr size_t O_W2DN = O_W2IN + (size_t)5632 * 1024 * 2;
constexpr size_t O_WINA = O_W2DN + (size_t)1024 * 2816 * 2;
constexpr size_t O_WGATE = O_WINA + (size_t)3840 * 1024 * 2;
constexpr size_t O_WUQ = O_WGATE + (size_t)3072 * 1024 * 2;
constexpr size_t O_WUK = O_WUQ + (size_t)1536 * 384 * 2;
constexpr size_t O_WUV = O_WUK + (size_t)1024 * 256 * 2;
constexpr size_t O_WMK = O_WUV + (size_t)1024 * 256 * 2;
constexpr size_t O_WMV = O_WMK + (size_t)1024 * 1024 * 2;
constexpr size_t O_WBR = O_WMV + (size_t)1024 * 1024 * 2;
constexpr size_t O_WOUT = O_WBR + (size_t)3 * 1024 * 1024 * 2;
constexpr size_t O_WRGA = O_WOUT + (size_t)1024 * 1024 * 2;
constexpr size_t O_WRGI = O_WRGA + (size_t)8 * 128 * 128 * 2;
constexpr size_t O_ROPE = O_WRGI + (size_t)8 * 128 * 128 * 2;
constexpr size_t O_MEMK = O_ROPE + (size_t)2048 * 32 * 8;
constexpr size_t O_MEMVT = O_MEMK + (size_t)TMEM * 1024 * 2;
constexpr size_t O_R = ((O_MEMVT + (size_t)TMEM * 1024 * 2 + MiB - 1) / MiB) * MiB;
constexpr size_t O_H = O_R;
constexpr size_t O_HID = O_H + 64 * MiB;
constexpr size_t O_MEMN = O_HID + 176 * MiB;
constexpr size_t O_ZX = O_H + 64 * MiB;
constexpr size_t O_ZG = O_ZX + 32 * MiB;
constexpr size_t O_ZMQ = O_ZG + 32 * MiB;
constexpr size_t O_ZL = O_ZMQ + 32 * MiB;
constexpr size_t O_CQN = O_ZL + 24 * MiB;
constexpr size_t O_CKVN = O_CQN + 12 * MiB;
constexpr size_t O_KROPE = O_CKVN + 8 * MiB;
constexpr size_t O_LAU = O_KROPE + 2 * MiB;
constexpr size_t O_SUMM = O_LAU + 64 * MiB;
constexpr size_t O_Q = O_SUMM + 1 * MiB;
constexpr size_t O_KNOPE = O_Q + 48 * MiB;
constexpr size_t O_VT = O_KNOPE + 32 * MiB;
constexpr size_t O_BAR = O_VT + 32 * MiB;
constexpr size_t O_END = O_BAR + 65536;
static_assert(O_END <= 512 * MiB, "workspace");
static_assert(O_MEMN + 8 * MiB <= 512 * MiB, "workspace");

constexpr int LDS_MAIN = 151552;
constexpr int LDS_BYTES = LDS_MAIN + 16;

__device__ __forceinline__ float bf2f(bf16_t b) { return __uint_as_float(((unsigned)b) << 16); }
__device__ __forceinline__ bf16_t f2bf(float f) { unsigned u = __float_as_uint(f); u += 0x7FFFu + ((u >> 16) & 1u); return (bf16_t)(u >> 16); }
typedef __bf16 bf16v2 __attribute__((ext_vector_type(2)));
__device__ __forceinline__ unsigned pk2(float lo, float hi) { const f32x2 v = {lo, hi}; const bf16v2 b = __builtin_convertvector(v, bf16v2); return __builtin_bit_cast(unsigned, b); }
__device__ __forceinline__ float lo_f(unsigned w) { return __uint_as_float(w << 16); }
__device__ __forceinline__ float hi_f(unsigned w) { return __uint_as_float(w & 0xffff0000u); }
__device__ __forceinline__ float sigmoidf_(float x) { return __builtin_amdgcn_rcpf(1.0f + __expf(-x)); }
__device__ __forceinline__ float gelu_tanh(float x) { const float t = 1.5957691216f * (x + 0.044715f * x * x * x); return x * __builtin_amdgcn_rcpf(1.0f + __expf(-t)); }
__device__ __forceinline__ float wave_sum(float v) { v += __shfl_xor(v, 32); v += __shfl_xor(v, 16); v += __shfl_xor(v, 8); v += __shfl_xor(v, 4); v += __shfl_xor(v, 2); v += __shfl_xor(v, 1); return v; }

__device__ __forceinline__ int opaque_tid() { int t = threadIdx.x; asm volatile("" : "+v"(t)); return t; }
struct Params { const float* in[27]; float* out; unsigned char* ws; int ph_lo, ph_hi; };

namespace pg8 {
constexpr int BM = 256, BK = 64, HALF = 128, HTB = HALF * BK * 2, NXCD = 8, WGM = 4;
__device__ __forceinline__ int lds_byte(int r, int c) { const int st = (r >> 4) * 2 + (c >> 5), rr = r & 15, cc = c & 31, ob = rr * 64 + cc * 2; return st * 1024 + (ob ^ (((ob >> 9) & 1) << 5)); }
__device__ __forceinline__ void stage_rc(int b, int& R, int& C) { const int st = b / 1024, sb = b % 1024, swz = sb ^ (((sb >> 9) & 1) << 5); R = (st >> 1) * 16 + swz / 64; C = (st & 1) * 32 + (swz % 64) / 2; }
__device__ __forceinline__ int perm32(int rho) { const int n = rho >> 4, i = rho & 15; return 8 * (i >> 2) + 4 * n + (i & 3); }

struct Unit { const char* A; const char* B; int pm, pn, aux; };

__device__ __forceinline__ void tile_of(int L, int nM, int nN, int& pm, int& pn) {
    const int nwg = nM * nN; int wgid = L;
    { const int q = nwg / NXCD, r = nwg % NXCD, xcd = wgid % NXCD, off = wgid / NXCD; wgid = (xcd < r ? xcd * (q + 1) : r * (q + 1) + (xcd - r) * q) + off; }
    const int nig = WGM * nN, gid = wgid / nig, fm = gid * WGM, gsz = (nM - fm) < WGM ? (nM - fm) : WGM;
    pm = fm + ((wgid % nig) % gsz); pn = (wgid % nig) / gsz;
}
struct Sched3 {
    const bf16_t *A0, *B0, *A1, *B1, *A2, *B2; int nM0, nN0, nM1, nN1, nM2, nN2; int G, c, K;
    __device__ __forceinline__ bool next(int i, Unit& u) const {
        int L = i * G + c; const size_t tstep = (size_t)BM * K * 2;
        const int n0 = nM0 * nN0, n1 = nM1 * nN1, n2 = nM2 * nN2;
        if (L < n0) { tile_of(L, nM0, nN0, u.pm, u.pn); u.A = (const char*)A0 + u.pm * tstep; u.B = (const char*)B0 + u.pn * tstep; u.aux = 0; return true; }
        L -= n0;
        if (L < n1) { tile_of(L, nM1, nN1, u.pm, u.pn); u.A = (const char*)A1 + u.pm * tstep; u.B = (const char*)B1 + u.pn * tstep; u.aux = 1; return true; }
        L -= n1;
        if (L < n2) { tile_of(L, nM2, nN2, u.pm, u.pn); u.A = (const char*)A2 + u.pm * tstep; u.B = (const char*)B2 + u.pn * tstep; u.aux = 2; return true; }
        return false;
    }
};
struct SchedMerge {
    const unsigned char* ws; size_t h2g_off; int G, c;
    __device__ __forceinline__ bool next(int i, Unit& u) const {
        const int tile = (i / 6) * G + c; if (tile >= (TG / 256) * 4) return false;
        const int sub = i % 6, b = sub >> 1, kind = sub & 1; const size_t tstep = (size_t)BM * 1024 * 2;
        u.pm = tile >> 2; u.pn = tile & 3; u.aux = sub;
        const size_t yoff = (size_t)(b == 0) * O_LAU + (size_t)(b == 1) * O_ZX + (size_t)(b == 2) * O_ZMQ;
        const size_t aoff = (size_t)(kind == 0) * h2g_off + (size_t)(kind != 0) * yoff;
        const size_t woff = (size_t)(kind == 0) * O_WGATE + (size_t)(kind != 0) * O_WBR;
        u.A = (const char*)ws + aoff + u.pm * tstep; u.B = (const char*)ws + woff + (size_t)(b * 4 + u.pn) * tstep; return true;
    }
};

template <class Epi, class Sched>
__device__ __forceinline__ void gemm_phase(LAS unsigned char* lds, const int K, const Sched& S, const Epi& E) {
    const int tid = opaque_tid(), wid = __builtin_amdgcn_readfirstlane(tid >> 6), lane = tid & 63, wr = wid >> 2, wc = wid & 3, fr = lane & 15, fq = lane >> 4;
    const int nt = K / BK;
    unsigned voffA[2], voffB[2];
#pragma unroll
    for (int i = 0; i < 2; ++i) { int R, C; stage_rc(tid * 16 + i * 8192, R, C); const int Rb = Epi::PERM ? ((R & ~31) + perm32(R & 31)) : R;
        voffA[i] = (unsigned)(R * K + C) * 2u; voffB[i] = (unsigned)(Rb * K + C) * 2u; }
    const size_t kstep = (size_t)(BK * 2);
    const size_t hstep = (size_t)HALF * K * 2;
    const unsigned ldsw = (unsigned)wid * 1024u;
    const int aoff = lds_byte(wr * 64 + fr, fq * 8), boff = lds_byte(wc * 32 + fr, fq * 8);
#define PG8_SA(b, h) (((b) * 2 + (h)) * HTB)
#define PG8_SB(b, h) ((4 + (b) * 2 + (h)) * HTB)
#define PG8_STAGE(bufoff, gbase, voff) do { _Pragma("unroll") for (int _i = 0; _i < 2; ++_i) \
        __builtin_amdgcn_global_load_lds((const unsigned*)((const char*)(gbase) + (voff)[_i]), (LAS unsigned*)(lds + (bufoff) + ldsw + _i * 8192), 16, 0, 0); } while (0)
#define PG8_LDA(dst, b, h) do { _Pragma("unroll") for (int m = 0; m < 4; ++m) _Pragma("unroll") for (int k = 0; k < 2; ++k) dst[m][k] = *(const LAS bf16x8*)(lds + PG8_SA(b, h) + aoff + m * 2048 + k * 1024); } while (0)
#define PG8_LDB(dst, b, h) do { _Pragma("unroll") for (int n = 0; n < 2; ++n) _Pragma("unroll") for (int k = 0; k < 2; ++k) dst[n][k] = *(const LAS bf16x8*)(lds + PG8_SB(b, h) + boff + n * 2048 + k * 1024); } while (0)
#define PG8_MMA(ai, bj, At, Bt) do { __builtin_amdgcn_s_setprio(1); _Pragma("unroll") for (int m = 0; m < 4; ++m) _Pragma("unroll") for (int n = 0; n < 2; ++n) _Pragma("unroll") for (int k = 0; k < 2; ++k) \
        acc[ai][bj][m][n] = __builtin_amdgcn_mfma_f32_16x16x32_bf16(Bt[n][k], At[m][k], acc[ai][bj][m][n], 0, 0, 0); __builtin_amdgcn_s_setprio(0); } while (0)
#define PG8_WAIT_V(n) asm volatile("s_waitcnt vmcnt(" #n ")" ::: "memory")
#define PG8_WAIT_L(n) asm volatile("s_waitcnt lgkmcnt(" #n ")" ::: "memory")
#define PG8_BAR __builtin_amdgcn_s_barrier()
#define PG8_SCHED __builtin_amdgcn_sched_barrier(0)
    Unit cur, nxt; int ui = 0;
    if (!S.next(0, cur)) return;
    f32x4 acc[2][2][4][2];
#pragma unroll
    for (int a = 0; a < 2; ++a)
#pragma unroll
        for (int b = 0; b < 2; ++b)
#pragma unroll
            for (int m = 0; m < 4; ++m)
#pragma unroll
                for (int n = 0; n < 2; ++n) acc[a][b][m][n] = (f32x4){0.f, 0.f, 0.f, 0.f};
    bf16x8 At[4][2], B0[2][2], B1[2][2];
    const char* cA = cur.A; const char* cB = cur.B;
    PG8_STAGE(PG8_SB(0, 0), cB, voffB); PG8_STAGE(PG8_SA(0, 0), cA, voffA); PG8_STAGE(PG8_SB(0, 1), cB + hstep, voffB); PG8_STAGE(PG8_SA(0, 1), cA + hstep, voffA);
    if (wr == 1) PG8_BAR;
    PG8_WAIT_V(4); PG8_BAR;
    PG8_STAGE(PG8_SB(1, 0), cB + kstep, voffB); PG8_STAGE(PG8_SA(1, 0), cA + kstep, voffA); PG8_STAGE(PG8_SB(1, 1), cB + hstep + kstep, voffB);
    PG8_WAIT_V(6); PG8_BAR;
    for (;;) {
        const bool has_next = S.next(ui + 1, nxt);
        const char* nA = has_next ? nxt.A : cA; const char* nB = has_next ? nxt.B : cB;
        for (int t = 0; t < nt; t += 2) {
            const bool last = (t == nt - 2);
            const char* a1 = cA + (size_t)(t + 1) * kstep;
            const char* a2 = last ? nA : cA + (size_t)(t + 2) * kstep; const char* b2 = last ? nB : cB + (size_t)(t + 2) * kstep;
            const char* a3 = a2 + kstep; const char* b3 = b2 + kstep;
            PG8_LDB(B0, 0, 0); PG8_SCHED; PG8_LDA(At, 0, 0); PG8_STAGE(PG8_SA(1, 1), a1 + hstep, voffA);
            PG8_WAIT_L(8); PG8_BAR; PG8_WAIT_L(0); PG8_MMA(0, 0, At, B0); PG8_BAR; PG8_SCHED;
            PG8_LDB(B1, 0, 1); PG8_STAGE(PG8_SB(0, 0), b2, voffB);
            PG8_BAR; PG8_WAIT_L(0); PG8_MMA(0, 1, At, B1); PG8_BAR;
            PG8_LDA(At, 0, 1); PG8_STAGE(PG8_SA(0, 0), a2, voffA);
            PG8_BAR; PG8_WAIT_L(0); PG8_MMA(1, 0, At, B0); PG8_BAR; PG8_SCHED;
            PG8_STAGE(PG8_SB(0, 1), b2 + hstep, voffB);
            PG8_WAIT_V(6); PG8_BAR; PG8_MMA(1, 1, At, B1); PG8_BAR;
            PG8_LDB(B0, 1, 0); PG8_SCHED; PG8_LDA(At, 1, 0); PG8_STAGE(PG8_SA(0, 1), a2 + hstep, voffA);
            PG8_WAIT_L(8); PG8_BAR; PG8_WAIT_L(0); PG8_MMA(0, 0, At, B0); PG8_BAR; PG8_SCHED;
            PG8_LDB(B1, 1, 1); PG8_STAGE(PG8_SB(1, 0), b3, voffB);
            PG8_BAR; PG8_WAIT_L(0); PG8_MMA(0, 1, At, B1); PG8_BAR;
            PG8_LDA(At, 1, 1); PG8_STAGE(PG8_SA(1, 0), a3, voffA);
            PG8_BAR; PG8_WAIT_L(0); PG8_MMA(1, 0, At, B0); PG8_BAR; PG8_SCHED;
            PG8_STAGE(PG8_SB(1, 1), b3 + hstep, voffB);
            PG8_WAIT_V(6); PG8_BAR; PG8_MMA(1, 1, At, B1); PG8_BAR;
        }
        E(acc, cur, wr, wc, fr, fq);
        if (!has_next) break;
#pragma unroll
        for (int a = 0; a < 2; ++a)
#pragma unroll
            for (int b = 0; b < 2; ++b)
#pragma unroll
                for (int m = 0; m < 4; ++m)
#pragma unroll
                    for (int n = 0; n < 2; ++n) acc[a][b][m][n] = (f32x4){0.f, 0.f, 0.f, 0.f};
        cur = nxt; cA = nA; cB = nB; ++ui;
    }
    PG8_WAIT_V(0);
    if (wr == 0) PG8_BAR;
    PG8_BAR;
#undef PG8_SA
#undef PG8_SB
#undef PG8_STAGE
#undef PG8_LDA
#undef PG8_LDB
#undef PG8_MMA
#undef PG8_WAIT_V
#undef PG8_WAIT_L
#undef PG8_BAR
#undef PG8_SCHED
}

typedef f32x4 Acc[2][2][4][2];
template <int ACT>
__device__ __forceinline__ void store_bf16_tile(const Acc& acc, bf16_t* O, int ld, int rowbase, int colbase, int wr, int wc, int fr, int fq, const float sc = 1.0f) {
    const int row0 = rowbase + wr * 64 + fr, col0 = colbase + wc * 32 + 8 * fq;
#pragma unroll
    for (int ai = 0; ai < 2; ++ai)
#pragma unroll
        for (int m = 0; m < 4; ++m) { bf16_t* rowp = O + (size_t)(row0 + ai * HALF + m * 16) * ld + col0;
#pragma unroll
            for (int bj = 0; bj < 2; ++bj) { f32x4 v0 = acc[ai][bj][m][0] * sc, v1 = acc[ai][bj][m][1] * sc;
                if (ACT == 1) {
#pragma unroll
                    for (int j = 0; j < 4; ++j) { v0[j] = gelu_tanh(v0[j]); v1[j] = gelu_tanh(v1[j]); } }
                u32x4 w; w.x = pk2(v0[0], v0[1]); w.y = pk2(v0[2], v0[3]); w.z = pk2(v1[0], v1[1]); w.w = pk2(v1[2], v1[3]);
                *(u32x4*)(rowp + bj * HALF) = w; } }
}
struct EpiFfnIn {
    static constexpr bool PERM = true;
    bf16_t* hid; bf16_t* memK; bf16_t* memVt;
    __device__ __forceinline__ void operator()(const Acc& acc, const Unit& u, int wr, int wc, int fr, int fq) const {
        if (u.aux == 0) {
            const int row0 = u.pm * BM + wr * 64 + fr, col0 = u.pn * HALF + wc * 32 + 8 * fq;
#pragma unroll
            for (int ai = 0; ai < 2; ++ai)
#pragma unroll
                for (int m = 0; m < 4; ++m) {
                    float o[8];
#pragma unroll
                    for (int n = 0; n < 2; ++n)
#pragma unroll
                        for (int j = 0; j < 4; ++j) { const float g = acc[ai][0][m][n][j], up = acc[ai][1][m][n][j]; o[n * 4 + j] = g * __builtin_amdgcn_rcpf(1.0f + __expf(-g)) * up; }
                    u32x4 w; w.x = pk2(o[0], o[1]); w.y = pk2(o[2], o[3]); w.z = pk2(o[4], o[5]); w.w = pk2(o[6], o[7]);
                    *(u32x4*)(hid + (size_t)(row0 + ai * HALF + m * 16) * FF + col0) = w; }
        } else if (u.aux == 1) store_bf16_tile<0>(acc, memK, 1024, u.pm * BM, u.pn * BM, wr, wc, fr, fq);
        else store_bf16_tile<0>(acc, memVt, TMEM, u.pm * BM, u.pn * BM, wr, wc, fr, fq);
    }
};
struct EpiResid {
    static constexpr bool PERM = false;
    const float* res; float* out; float scale;
    __device__ __forceinline__ void operator()(const Acc& acc, const Unit& u, int wr, int wc, int fr, int fq) const {
        const int row0 = u.pm * BM + wr * 64 + fr, col0 = u.pn * BM + wc * 32 + 4 * fq;
#pragma unroll
        for (int ai = 0; ai < 2; ++ai) {
            f32x4 r[4][2][2];
#pragma unroll
            for (int m = 0; m < 4; ++m) { const size_t off = (size_t)(row0 + ai * HALF + m * 16) * D + col0;
#pragma unroll
                for (int bj = 0; bj < 2; ++bj)
#pragma unroll
                    for (int n = 0; n < 2; ++n) r[m][bj][n] = *(const f32x4*)(res + off + bj * HALF + n * 16); }
            asm volatile("" ::: "memory");
#pragma unroll
            for (int m = 0; m < 4; ++m) { const size_t off = (size_t)(row0 + ai * HALF + m * 16) * D + col0;
#pragma unroll
                for (int bj = 0; bj < 2; ++bj)
#pragma unroll
                    for (int n = 0; n < 2; ++n) *(f32x4*)(out + off + bj * HALF + n * 16) = r[m][bj][n] + acc[ai][bj][m][n] * scale; }
            asm volatile("" ::: "memory");
        }
    }
};
struct EpiInProj {
    static constexpr bool PERM = true;
    bf16_t *zx, *zg, *zmq, *zl;
    __device__ __forceinline__ void operator()(const Acc& acc, const Unit& u, int wr, int wc, int fr, int fq) const {
        const int pn = u.pn;
        if (pn < 4) store_bf16_tile<0>(acc, zx, 1024, u.pm * BM, pn * BM, wr, wc, fr, fq);
        else if (pn < 8) store_bf16_tile<1>(acc, zg, 1024, u.pm * BM, (pn - 4) * BM, wr, wc, fr, fq);
        else if (pn < 12) store_bf16_tile<0>(acc, zmq, 1024, u.pm * BM, (pn - 8) * BM, wr, wc, fr, fq);
        else store_bf16_tile<0>(acc, zl, 768, u.pm * BM, (pn - 12) * BM, wr, wc, fr, fq);
    }
};
struct EpiPlain1 {
    static constexpr bool PERM = true;
    bf16_t* O; int ld; float scale;
    __device__ __forceinline__ void operator()(const Acc& acc, const Unit& u, int wr, int wc, int fr, int fq) const {
        store_bf16_tile<0>(acc, O, ld, u.pm * BM, u.pn * BM, wr, wc, fr, fq, scale);
    }
};
struct EpiMerge {
    static constexpr bool PERM = true;
    bf16_t* gtmp; float* mrg; bf16_t* merged; const float* bgate;
    __device__ __forceinline__ void operator()(const Acc& acc, const Unit& u, int wr, int wc, int fr, int fq) const {
        const int b = u.aux >> 1, kind = u.aux & 1;
        const int row0 = u.pm * BM + wr * 64 + fr, col0 = u.pn * BM + wc * 32 + 8 * fq;
        if (kind == 0) {
#pragma unroll
            for (int bj = 0; bj < 2; ++bj) { const f32x4 b0 = *(const f32x4*)(bgate + b * D + col0 + bj * HALF), b1 = *(const f32x4*)(bgate + b * D + col0 + bj * HALF + 4);
#pragma unroll
                for (int ai = 0; ai < 2; ++ai)
#pragma unroll
                    for (int m = 0; m < 4; ++m) { f32x4 v0 = acc[ai][bj][m][0] + b0, v1 = acc[ai][bj][m][1] + b1;
#pragma unroll
                        for (int j = 0; j < 4; ++j) { v0[j] = sigmoidf_(v0[j]); v1[j] = sigmoidf_(v1[j]); }
                        u32x4 w; w.x = pk2(v0[0], v0[1]); w.y = pk2(v0[2], v0[3]); w.z = pk2(v1[0], v1[1]); w.w = pk2(v1[2], v1[3]);
                        *(u32x4*)(gtmp + (size_t)(row0 + ai * HALF + m * 16) * D + col0 + bj * HALF) = w; } }
        } else {
            bf16_t* mrgb = (bf16_t*)mrg;
#pragma unroll
            for (int ai = 0; ai < 2; ++ai) {
                u32x4 gq[4][2], mq[4][2];
#pragma unroll
                for (int m = 0; m < 4; ++m)
#pragma unroll
                    for (int bj = 0; bj < 2; ++bj) { const size_t off = (size_t)(row0 + ai * HALF + m * 16) * D + col0 + bj * HALF;
                        gq[m][bj] = *(const u32x4*)(gtmp + off);
                        mq[m][bj] = (u32x4){0u, 0u, 0u, 0u}; if (b > 0) mq[m][bj] = *(const u32x4*)(mrgb + off); }
                asm volatile("" ::: "memory");
#pragma unroll
                for (int m = 0; m < 4; ++m)
#pragma unroll
                    for (int bj = 0; bj < 2; ++bj) { const size_t off = (size_t)(row0 + ai * HALF + m * 16) * D + col0 + bj * HALF;
                        const u32x4 g = gq[m][bj], q = mq[m][bj];
                        f32x4 v0, v1; v0[0] = lo_f(g.x); v0[1] = hi_f(g.x); v0[2] = lo_f(g.y); v0[3] = hi_f(g.y); v1[0] = lo_f(g.z); v1[1] = hi_f(g.z); v1[2] = lo_f(g.w); v1[3] = hi_f(g.w);
                        f32x4 p0, p1; p0[0] = lo_f(q.x); p0[1] = hi_f(q.x); p0[2] = lo_f(q.y); p0[3] = hi_f(q.y); p1[0] = lo_f(q.z); p1[1] = hi_f(q.z); p1[2] = lo_f(q.w); p1[3] = hi_f(q.w);
                        v0 = v0 * acc[ai][bj][m][0] + p0; v1 = v1 * acc[ai][bj][m][1] + p1;
                        u32x4 w; w.x = pk2(v0[0], v0[1]); w.y = pk2(v0[2], v0[3]); w.z = pk2(v1[0], v1[1]); w.w = pk2(v1[2], v1[3]);
                        if (b < 2) *(u32x4*)(mrgb + off) = w; else *(u32x4*)(merged + off) = w; }
                asm volatile("" ::: "memory");
            }
        }
    }
};
}

__device__ __forceinline__ int wt_srccol(int map, int n0) {
    switch (map) {
        case 1: { const int pn = n0 >> 8, bj = (n0 >> 7) & 1, i = n0 & 127; return bj * FF + pn * 128 + i; }
        case 2: return n0 < 3072 ? 704 + n0 : (n0 < 3776 ? n0 - 3072 : -1);
        case 3: return 3776 + n0;
        case 4: return (n0 >> 7) * 256 + (n0 & 127);
        case 5: return (n0 >> 7) * 256 + 128 + (n0 & 127);
        case 6: return 1024 + n0;
        default: return n0;
    }
}
template <bool WEIGHTED>
__device__ __forceinline__ void wt_job(const float* __restrict__ src, int src_ld, bf16_t* __restrict__ dst, int K, int Np, int map, LAS unsigned char* lds, int G, int c) {
    const int tid = opaque_tid(), wid = tid >> 6, lane = tid & 63, kg = lane >> 3, ng = lane & 7; const int tk_n = K / 64, tn_n = Np / 32;
    const int hw = (G >> 1) * 8;
    const bool light = WEIGHTED && c < (G >> 1);
    const int w0 = WEIGHTED ? (light ? c * 8 + wid : (c - (G >> 1)) * 8 + wid) : c * 8 + wid;
    for (int u = w0; ; u += (WEIGHTED ? hw : G * 8)) {
        const int t = !WEIGHTED ? u : (light ? (u >> 1) * 10 + 8 + (u & 1) : (u >> 3) * 10 + (u & 7));
        if (t >= tk_n * tn_n) break;
        const int tn = t / tk_n, tk = t % tk_n, n0 = tn * 32, k0 = tk * 64; const int sc = wt_srccol(map, n0);
        f32x4 v[8];
#pragma unroll
        for (int j = 0; j < 8; ++j) { v[j] = (f32x4){0.f, 0.f, 0.f, 0.f}; if (sc >= 0) v[j] = *(const f32x4*)(src + (size_t)(k0 + kg * 8 + j) * src_ld + sc + ng * 4); }
#pragma unroll
        for (int i = 0; i < 4; ++i) { u32x4 w; w.x = pk2(v[0][i], v[1][i]); w.y = pk2(v[2][i], v[3][i]); w.z = pk2(v[4][i], v[5][i]); w.w = pk2(v[6][i], v[7][i]);
            *(u32x4*)(dst + (size_t)(n0 + ng * 4 + i) * K + k0 + kg * 8) = w; }
    }
}
constexpr int NR = 4;
__device__ __forceinline__ void rmsnorm_rows_bf16(const float* __restrict__ X, const float* __restrict__ g, bf16_t* __restrict__ out, int nrows, int G, int c) {
    const int tid_ = opaque_tid(); const int wid = tid_ >> 6, lane = tid_ & 63;
    f32x4 gv[4];
#pragma unroll
    for (int i = 0; i < 4; ++i) gv[i] = ((const f32x4*)g)[lane + 64 * i];
    for (int r = (c * 8 + wid) * NR; r < nrows; r += G * 8 * NR) {
        f32x4 v[NR][4]; float ss[NR]; _Pragma("unroll") for (int q = 0; q < NR; ++q) ss[q] = 0.f;
#pragma unroll
        for (int q = 0; q < NR; ++q)
#pragma unroll
            for (int i = 0; i < 4; ++i) v[q][i] = ((const f32x4*)(X + (size_t)(r + q) * D))[lane + 64 * i];
#pragma unroll
        for (int q = 0; q < NR; ++q) {
#pragma unroll
            for (int i = 0; i < 4; ++i) ss[q] += v[q][i][0] * v[q][i][0] + v[q][i][1] * v[q][i][1] + v[q][i][2] * v[q][i][2] + v[q][i][3] * v[q][i][3];
            ss[q] = wave_sum(ss[q]); const float rstd = rsqrtf(ss[q] * (1.0f / D) + 1e-6f);
#pragma unroll
            for (int i = 0; i < 4; ++i) { u32x2 w; w.x = pk2(v[q][i][0] * rstd * gv[i][0], v[q][i][1] * rstd * gv[i][1]); w.y = pk2(v[q][i][2] * rstd * gv[i][2], v[q][i][3] * rstd * gv[i][3]);
                *(u32x2*)(out + (size_t)(r + q) * D + (lane + 64 * i) * 4) = w; }
        }
    }
}
__device__ __forceinline__ void rmsnorm_rows_f32_inplace(float* X, const float* __restrict__ g, int nrows, int G, int c) {
    const int tid_ = opaque_tid(); const int wid = tid_ >> 6, lane = tid_ & 63;
    f32x4 gv[4];
#pragma unroll
    for (int i = 0; i < 4; ++i) gv[i] = ((const f32x4*)g)[lane + 64 * i];
    for (int r = (c * 8 + wid) * NR; r < nrows; r += G * 8 * NR) {
        f32x4 v[NR][4]; float ss[NR]; _Pragma("unroll") for (int q = 0; q < NR; ++q) ss[q] = 0.f;
#pragma unroll
        for (int q = 0; q < NR; ++q)
#pragma unroll
            for (int i = 0; i < 4; ++i) v[q][i] = ((const f32x4*)(X + (size_t)(r + q) * D))[lane + 64 * i];
        asm volatile("" ::: "memory");
#pragma unroll
        for (int q = 0; q < NR; ++q) {
#pragma unroll
            for (int i = 0; i < 4; ++i) ss[q] += v[q][i][0] * v[q][i][0] + v[q][i][1] * v[q][i][1] + v[q][i][2] * v[q][i][2] + v[q][i][3] * v[q][i][3];
            ss[q] = wave_sum(ss[q]); const float rstd = rsqrtf(ss[q] * (1.0f / D) + 1e-6f);
#pragma unroll
            for (int i = 0; i < 4; ++i) ((f32x4*)(X + (size_t)(r + q) * D))[lane + 64 * i] = v[q][i] * rstd * gv[i];
        }
    }
}
__device__ __forceinline__ void latent_rows(const bf16_t* __restrict__ zl, const float* __restrict__ qn, const float* __restrict__ kvn, const f32x2* __restrict__ rope, bf16_t* __restrict__ cqn, bf16_t* __restrict__ ckvn, bf16_t* __restrict__ krope, int G, int c) {
    const int tid_ = opaque_tid(); const int wid = tid_ >> 6, lane = tid_ & 63;
    for (int r = c * 8 + wid; r < TG; r += G * 8) {
        const bf16_t* zp = zl + (size_t)r * 768;
        float a[6]; float ss = 0.f;
        unsigned wq[3];
#pragma unroll
        for (int i = 0; i < 3; ++i) wq[i] = *(const unsigned*)(zp + lane * 2 + 128 * i);
        const u32x2 w2 = *(const u32x2*)(zp + 384 + lane * 4); const float v = bf2f(zp[640 + lane]);
        const f32x2 cs = rope[(r & (SEQ - 1)) * 32 + (lane & 31)];
#pragma unroll
        for (int i = 0; i < 3; ++i) { const unsigned w = wq[i]; a[2 * i] = lo_f(w); a[2 * i + 1] = hi_f(w); ss += a[2 * i] * a[2 * i] + a[2 * i + 1] * a[2 * i + 1]; }
        ss = wave_sum(ss); const float rq = rsqrtf(ss * (1.0f / 384.0f) + 1e-6f);
#pragma unroll
        for (int i = 0; i < 3; ++i) { const int col = lane * 2 + 128 * i; *(unsigned*)(cqn + (size_t)r * 384 + col) = pk2(a[2 * i] * rq * qn[col], a[2 * i + 1] * rq * qn[col + 1]); }
        float k4[4] = {lo_f(w2.x), hi_f(w2.x), lo_f(w2.y), hi_f(w2.y)};
        float s2 = k4[0] * k4[0] + k4[1] * k4[1] + k4[2] * k4[2] + k4[3] * k4[3]; s2 = wave_sum(s2); const float rk = rsqrtf(s2 * (1.0f / 256.0f) + 1e-6f);
        { const int col = lane * 4; u32x2 o; o.x = pk2(k4[0] * rk * kvn[col], k4[1] * rk * kvn[col + 1]); o.y = pk2(k4[2] * rk * kvn[col + 2], k4[3] * rk * kvn[col + 3]); *(u32x2*)(ckvn + (size_t)r * 256 + col) = o; }
        const float pv = __shfl_xor(v, 32);
        const float o = lane < 32 ? v * cs.x - pv * cs.y : v * cs.x + pv * cs.y;
        krope[(size_t)r * 64 + lane] = f2bf(o);
    }
}

__device__ __forceinline__ void rglru_tile(LAS unsigned char* lds, const Params& p, const bf16_t* zx, unsigned* lau, f32x2* summ, int gb, int tc, int n) {
    const int tid = opaque_tid(), wid = tid >> 6, lane = tid & 63, l15 = lane & 15, quad = lane >> 4;
    const bf16_t* WA = (const bf16_t*)(p.ws + O_WRGA) + (size_t)n * 128 * 128; const bf16_t* WI = (const bf16_t*)(p.ws + O_WRGI) + (size_t)n * 128 * 128;
    LAS unsigned char* xcs = lds;
    LAS unsigned* laus = (LAS unsigned*)(lds + 34816);
    LAS f32x2* segs = (LAS f32x2*)(lds + 34816 + 65536);
    const size_t tok0 = (size_t)gb * SEQ + tc * 128;
    const int e = wid * 16 + l15;
    bf16x8 fa[4], fi[4];
#pragma unroll
    for (int ks = 0; ks < 4; ++ks) { fa[ks] = *(const bf16x8*)(WA + (size_t)e * 128 + ks * 32 + quad * 8); fi[ks] = *(const bf16x8*)(WI + (size_t)e * 128 + ks * 32 + quad * 8); }
    const float bav = p.in[15][n * 128 + e], biv = p.in[17][n * 128 + e]; const float sp8 = -8.0f * log1pf(__expf(-p.in[18][n * 128 + e]));
    {
        const int cg8 = tid & 15, tg = tid >> 4, ch0 = n * 128 + cg8 * 8, t0 = tg * 4;
        float xin[7][8];
#pragma unroll
        for (int k = 0; k < 7; ++k) { const int t = t0 - 3 + k; u32x4 w = (u32x4){0u, 0u, 0u, 0u};
            if (tc * 128 + t >= 0) w = *(const u32x4*)(zx + (tok0 + t) * 1024 + ch0);
            xin[k][0] = lo_f(w.x); xin[k][1] = hi_f(w.x); xin[k][2] = lo_f(w.y); xin[k][3] = hi_f(w.y); xin[k][4] = lo_f(w.z); xin[k][5] = hi_f(w.z); xin[k][6] = lo_f(w.w); xin[k][7] = hi_f(w.w); }
        const float* cw = p.in[12]; const float* cb = p.in[13];
        float w0[8], w1[8], w2[8], w3[8], bb[8];
#pragma unroll
        for (int j = 0; j < 8; ++j) { w0[j] = cw[ch0 + j]; w1[j] = cw[1024 + ch0 + j]; w2[j] = cw[2048 + ch0 + j]; w3[j] = cw[3072 + ch0 + j]; bb[j] = cb[ch0 + j]; }
#pragma unroll
        for (int tt = 0; tt < 4; ++tt) { float o[8];
#pragma unroll
            for (int j = 0; j < 8; ++j) o[j] = w0[j] * xin[tt][j] + w1[j] * xin[tt + 1][j] + w2[j] * xin[tt + 2][j] + w3[j] * xin[tt + 3][j] + bb[j];
            u32x4 w; w.x = pk2(o[0], o[1]); w.y = pk2(o[2], o[3]); w.z = pk2(o[4], o[5]); w.w = pk2(o[6], o[7]);
            *(LAS u32x4*)(xcs + (t0 + tt) * 272 + cg8 * 16) = w; }
    }
    __syncthreads();
    {
#pragma unroll 2
        for (int tt = 0; tt < 8; ++tt) {
            f32x4 aa = (f32x4){0.f, 0.f, 0.f, 0.f}, ai = (f32x4){0.f, 0.f, 0.f, 0.f};
#pragma unroll
            for (int ks = 0; ks < 4; ++ks) { const bf16x8 af = *(const LAS bf16x8*)(xcs + (tt * 16 + l15) * 272 + ks * 64 + quad * 16);
                aa = __builtin_amdgcn_mfma_f32_16x16x32_bf16(af, fa[ks], aa, 0, 0, 0);
                ai = __builtin_amdgcn_mfma_f32_16x16x32_bf16(af, fi[ks], ai, 0, 0, 0); }
#pragma unroll
            for (int j = 0; j < 4; ++j) { const int t = tt * 16 + quad * 4 + j;
                const float r = sigmoidf_(aa[j] + bav), ig = sigmoidf_(ai[j] + biv);
                const float la = r * sp8; const float x2 = 2.0f * la;
                const float ser = -x2 * (1.0f + x2 * (0.5f + x2 * (0.16666667f + x2 * (0.041666667f + x2 * (0.0083333333f + x2 * 0.0013888889f)))));
                const float em = x2 > -0.3f ? ser : 1.0f - __expf(x2);
                const float xcv = bf2f(*(const LAS bf16_t*)(xcs + t * 272 + e * 2));
                const float uu = sqrtf(em) * ig * xcv;
                laus[t * 128 + e] = pk2(la, uu); }
        }
    }
    __syncthreads();
    {
        const int ch = tid & 127, seg = tid >> 7; float P = 1.f, H = 0.f;
#pragma unroll 4
        for (int t = seg * 32; t < seg * 32 + 32; ++t) { const unsigned w = laus[t * 128 + ch]; const float a = __expf(lo_f(w)); P *= a; H = a * H + hi_f(w); }
        segs[seg * 128 + ch] = (f32x2){P, H};
#pragma unroll
        for (int i = 0; i < 8; ++i) { const int id = i * 512 + tid, row = id >> 5, c4 = id & 31;
            *(u32x4*)(lau + (tok0 + row) * 1024 + n * 128 + c4 * 4) = *(const LAS u32x4*)(laus + row * 128 + c4 * 4); }
    }
    __syncthreads();
    if (tid < 128) { f32x2 s0 = segs[tid]; float P = s0.x, H = s0.y;
#pragma unroll
        for (int s = 1; s < 4; ++s) { const f32x2 sv = segs[s * 128 + tid]; H = sv.x * H + sv.y; P *= sv.x; }
        summ[(size_t)(gb * 16 + tc) * 1024 + n * 128 + tid] = (f32x2){P, H}; }
    __syncthreads();
}
__device__ __forceinline__ void scan_apply(const unsigned* __restrict__ lau, const f32x2* __restrict__ summ, const bf16_t* __restrict__ zg, bf16_t* __restrict__ yb, int gb, int tc, int half) {
    const int ch = half * 512 + opaque_tid(); float h = 0.f;
    const size_t base = ((size_t)gb * SEQ + tc * 128) * 1024 + ch;
    unsigned wv[16]; bf16_t gv[16];
#pragma unroll
    for (int i = 0; i < 16; ++i) { wv[i] = lau[base + (size_t)i * 1024]; gv[i] = zg[base + (size_t)i * 1024]; }
    f32x2 sv[15];
#pragma unroll
    for (int k = 0; k < 15; ++k) { sv[k] = (f32x2){1.f, 0.f}; if (k < tc) sv[k] = summ[(size_t)(gb * 16 + k) * 1024 + ch]; }
#pragma unroll
    for (int k = 0; k < 15; ++k) h = sv[k].x * h + sv[k].y;
#pragma unroll 1
    for (int tb = 0; tb < 8; ++tb) {
        unsigned wn[16]; bf16_t gn[16];
        if (tb < 7) {
#pragma unroll
            for (int i = 0; i < 16; ++i) { wn[i] = lau[base + (size_t)((tb + 1) * 16 + i) * 1024]; gn[i] = zg[base + (size_t)((tb + 1) * 16 + i) * 1024]; } }
#pragma unroll
        for (int i = 0; i < 16; ++i) { const float a = __expf(lo_f(wv[i])); h = a * h + hi_f(wv[i]); yb[base + (size_t)(tb * 16 + i) * 1024] = f2bf(h * bf2f(gv[i])); }
#pragma unroll
        for (int i = 0; i < 16; ++i) { wv[i] = wn[i]; gv[i] = gn[i]; }
    }
}

template <int DQK, int DV, int QT, int DK1, bool ROPE>
__device__ __forceinline__ void attn_item(LAS unsigned char* lds, const bf16_t* Q, int ldq, const bf16_t* K1, int ldk1, const bf16_t* K2, int ldk2,
                                          const bf16_t* Vt, int ldvt, bf16_t* O, int ldo, int ntiles, int wave_tiles, float c_scale, const f32x2* rope, int pos0) {
    constexpr int KSTR = DQK * 2 + 32, VSTR = 160, KBYTES = 64 * KSTR, BUF = KBYTES + DV * VSTR;
    static_assert(2 * BUF <= LDS_MAIN, "attention LDS");
    constexpr int NKS = DQK / 32, NDT = DV / 16, KCH = DQK / 8;
    constexpr int NKL = 64 * KCH / 512, NVL = DV * 8 / 512;
    const int tid = opaque_tid(), wid = tid >> 6, lane = tid & 63, l15 = lane & 15, quad = lane >> 4;
    const int wrow0 = wid * QT * 16;
    bf16x8 qf[QT][NKS];
#pragma unroll
    for (int qt = 0; qt < QT; ++qt) {
        const bf16_t* qp = Q + (size_t)(wrow0 + qt * 16 + l15) * ldq + quad * 8;
#pragma unroll
        for (int ks = 0; ks < NKS; ++ks) qf[qt][ks] = *(const bf16x8*)(qp + ks * 32);
        if (ROPE) {
            const f32x2* rp = rope + (size_t)(pos0 + wrow0 + qt * 16 + l15) * 32 + quad * 8;
            bf16x8 x1 = qf[qt][NKS - 2], x2 = qf[qt][NKS - 1];
#pragma unroll
            for (int e = 0; e < 8; ++e) { const f32x2 cs = rp[e]; const float a = bf2f((bf16_t)x1[e]), b = bf2f((bf16_t)x2[e]);
                x1[e] = (short)f2bf(a * cs.x - b * cs.y); x2[e] = (short)f2bf(b * cs.x + a * cs.y); }
            qf[qt][NKS - 2] = x1; qf[qt][NKS - 1] = x2;
        }
#pragma unroll
        for (int ks = 0; ks < (ROPE ? 0 : NKS); ++ks) { bf16x8 x = qf[qt][ks];
#pragma unroll
            for (int e = 0; e < 8; ++e) x[e] = (short)f2bf(bf2f((bf16_t)x[e]) * c_scale);
            qf[qt][ks] = x; }
    }
    f32x4 o[NDT][QT];
#pragma unroll
    for (int dt = 0; dt < NDT; ++dt)
#pragma unroll
        for (int qt = 0; qt < QT; ++qt) o[dt][qt] = (f32x4){0.f, 0.f, 0.f, 0.f};
    float mrow[QT], lrow[QT];
#pragma unroll
    for (int qt = 0; qt < QT; ++qt) { mrow[qt] = -1e30f; lrow[qt] = 0.f; }

    constexpr int C1 = DK1 / 8, C2 = (DQK - DK1) / 8, NK1 = 64 * C1 / 512, NK2 = 64 * C2 / 512;
    static_assert(NK1 * 512 == 64 * C1 && NK2 * 512 == 64 * C2 && NK1 + NK2 == NKL, "chunking");
    u32x4 kst1[NK1], kst2[NK2 ? NK2 : 1], vst[NVL];
    unsigned k1o[NK1], k2o[NK2 ? NK2 : 1], vo[NVL];
#pragma unroll
    for (int i = 0; i < NK1; ++i) { const int ci = tid + 512 * i; k1o[i] = (unsigned)((ci / C1) * ldk1 + (ci % C1) * 8); }
#pragma unroll
    for (int i = 0; i < NK2; ++i) { const int ci = tid + 512 * i; k2o[i] = (unsigned)((ci / (C2 ? C2 : 1)) * ldk2 + (ci % (C2 ? C2 : 1)) * 8); }
#pragma unroll
    for (int i = 0; i < NVL; ++i) { const int ci = tid + 512 * i; vo[i] = (unsigned)((ci >> 3) * ldvt + (ci & 7) * 8); }
#define ATT_LOAD(j) do { const bf16_t* k1p = K1 + (size_t)(j) * 64 * ldk1; const bf16_t* k2p = K2 + (size_t)(j) * 64 * ldk2; const bf16_t* vp_ = Vt + (size_t)(j) * 64; \
        _Pragma("unroll") for (int i = 0; i < NK1; ++i) kst1[i] = *(const u32x4*)(k1p + k1o[i]); \
        _Pragma("unroll") for (int i = 0; i < NK2; ++i) kst2[i] = *(const u32x4*)(k2p + k2o[i]); \
        _Pragma("unroll") for (int i = 0; i < NVL; ++i) vst[i] = *(const u32x4*)(vp_ + vo[i]); } while (0)
#define KSLOT(k) ((((k) >> 5) * 2 + (((k) >> 2) & 1)) * 16 + (((k) >> 3) & 3) * 4 + ((k) & 3))
#define ATT_WRITE(b) do { LAS unsigned char* kb_ = lds + (b) * BUF; \
        _Pragma("unroll") for (int i = 0; i < NK1; ++i) { const int ci = tid + 512 * i; *(LAS u32x4*)(kb_ + KSLOT(ci / C1) * KSTR + (ci % C1) * 16) = kst1[i]; } \
        _Pragma("unroll") for (int i = 0; i < NK2; ++i) { const int ci = tid + 512 * i; *(LAS u32x4*)(kb_ + KSLOT(ci / (C2 ? C2 : 1)) * KSTR + DK1 * 2 + (ci % (C2 ? C2 : 1)) * 16) = kst2[i]; } \
        _Pragma("unroll") for (int i = 0; i < NVL; ++i) { const int ci = tid + 512 * i; *(LAS u32x4*)(kb_ + KBYTES + (ci >> 3) * VSTR + (ci & 7) * 16) = vst[i]; } } while (0)
    ATT_LOAD(0); ATT_WRITE(0);
    __syncthreads();
    for (int j = 0; j < ntiles; ++j) {
        const bool more = (j + 1 < ntiles);
        if (more) ATT_LOAD(j + 1);
        __builtin_amdgcn_sched_barrier(0);
        if (j < wave_tiles) {
            const LAS unsigned char* kb = lds + (j & 1) * BUF; const LAS unsigned char* vb = kb + KBYTES;
            f32x4 s[4][QT];
#pragma unroll
            for (int kt = 0; kt < 4; ++kt)
#pragma unroll
                for (int qt = 0; qt < QT; ++qt) s[kt][qt] = (f32x4){0.f, 0.f, 0.f, 0.f};
            {
                bf16x8 kf[2][4];
#pragma unroll
                for (int kt = 0; kt < 4; ++kt) kf[0][kt] = *(const LAS bf16x8*)(kb + (kt * 16 + l15) * KSTR + quad * 16);
#pragma unroll
                for (int ks = 0; ks < NKS; ++ks) {
                    if (ks + 1 < NKS) {
#pragma unroll
                        for (int kt = 0; kt < 4; ++kt) kf[(ks + 1) & 1][kt] = *(const LAS bf16x8*)(kb + (kt * 16 + l15) * KSTR + (ks + 1) * 64 + quad * 16); }
#pragma unroll
                    for (int kt = 0; kt < 4; ++kt)
#pragma unroll
                        for (int qt = 0; qt < QT; ++qt) s[kt][qt] = __builtin_amdgcn_mfma_f32_16x16x32_bf16(kf[ks & 1][kt], qf[qt][ks], s[kt][qt], 0, 0, 0);
                    __builtin_amdgcn_sched_barrier(0);
                }
            }
            bf16x8 pf[QT][2];
#pragma unroll
            for (int qt = 0; qt < QT; ++qt) {
                float mx = -1e30f;
#pragma unroll
                for (int kt = 0; kt < 4; ++kt)
#pragma unroll
                    for (int jj = 0; jj < 4; ++jj) mx = fmaxf(mx, s[kt][qt][jj]);
                if (__builtin_amdgcn_ballot_w64(mx > mrow[qt] + 8.0f) != 0ull) {
                    mx = fmaxf(mx, __shfl_xor(mx, 16)); mx = fmaxf(mx, __shfl_xor(mx, 32));
                    const float mnew = fmaxf(mrow[qt], mx); const float alpha = __builtin_amdgcn_exp2f(mrow[qt] - mnew); mrow[qt] = mnew; lrow[qt] *= alpha;
#pragma unroll
                    for (int dt = 0; dt < NDT; ++dt) o[dt][qt] = o[dt][qt] * alpha; }
                const float mcur = mrow[qt];
                float ps = 0.f;
#pragma unroll
                for (int kt = 0; kt < 4; ++kt)
#pragma unroll
                    for (int jj = 0; jj < 4; ++jj) { const float pv = __builtin_amdgcn_exp2f(s[kt][qt][jj] - mcur); s[kt][qt][jj] = pv; ps += pv; }
                lrow[qt] += ps;
#pragma unroll
                for (int s2 = 0; s2 < 2; ++s2) { u32x4 w; w.x = pk2(s[2 * s2][qt][0], s[2 * s2][qt][1]); w.y = pk2(s[2 * s2][qt][2], s[2 * s2][qt][3]);
                    w.z = pk2(s[2 * s2 + 1][qt][0], s[2 * s2 + 1][qt][1]); w.w = pk2(s[2 * s2 + 1][qt][2], s[2 * s2 + 1][qt][3]); pf[qt][s2] = __builtin_bit_cast(bf16x8, w); }
            }
            {
                constexpr int NST = 2 * (NDT / 4);
                bf16x8 vf[2][4];
#define ATT_VLOAD(buf, st) do { const int s2_ = (st) / (NDT / 4), dg_ = (st) % (NDT / 4); _Pragma("unroll") for (int d4 = 0; d4 < 4; ++d4) \
                    vf[buf][d4] = *(const LAS bf16x8*)(vb + ((dg_ * 4 + d4) * 16 + l15) * VSTR + s2_ * 64 + quad * 16); } while (0)
                ATT_VLOAD(0, 0);
#pragma unroll
                for (int st = 0; st < NST; ++st) {
                    if (st + 1 < NST) ATT_VLOAD((st + 1) & 1, st + 1);
                    const int s2 = st / (NDT / 4), dg = st % (NDT / 4);
#pragma unroll
                    for (int d4 = 0; d4 < 4; ++d4)
#pragma unroll
                        for (int qt = 0; qt < QT; ++qt) o[dg * 4 + d4][qt] = __builtin_amdgcn_mfma_f32_16x16x32_bf16(vf[st & 1][d4], pf[qt][s2], o[dg * 4 + d4][qt], 0, 0, 0);
                    __builtin_amdgcn_sched_barrier(0);
                }
#undef ATT_VLOAD
            }
        }
        if (more) ATT_WRITE((j + 1) & 1);
        __syncthreads();
    }
#undef ATT_LOAD
#undef ATT_WRITE
#undef KSLOT
#pragma unroll
    for (int qt = 0; qt < QT; ++qt) {
        float l = lrow[qt]; l += __shfl_xor(l, 16); l += __shfl_xor(l, 32); const float inv = 1.0f / l;
        bf16_t* op = O + (size_t)(wrow0 + qt * 16 + l15) * ldo + quad * 4;
#pragma unroll
        for (int dt = 0; dt < NDT; ++dt) { u32x2 w; w.x = pk2(o[dt][qt][0] * inv, o[dt][qt][1] * inv); w.y = pk2(o[dt][qt][2] * inv, o[dt][qt][3] * inv); *(u32x2*)(op + dt * 16) = w; }
    }
}


#define XB_TMO      128
#define XB_XCNT(j)  (256  + 64 * (j))
#define XB_XSUB(j)  (1280 + 64 * (j))
#define XB_XGEN(j)  (2304 + 64 * (j))
#define XB_TOP      3328
#define XB_TOPGEN   3392
#define XCD_BAR_WORDS 3456
#define XB_SPIN_CAP (1u << 22)
__device__ __forceinline__ unsigned xb_ld(unsigned* p)              { return __hip_atomic_load(p, __ATOMIC_RELAXED, __HIP_MEMORY_SCOPE_AGENT); }
__device__ __forceinline__ unsigned xb_add(unsigned* p, unsigned v) { return __hip_atomic_fetch_add(p, v, __ATOMIC_RELAXED, __HIP_MEMORY_SCOPE_AGENT); }
__device__ __forceinline__ unsigned xb_xcc_id() { return (unsigned)__builtin_amdgcn_s_getreg((3 << 11) | 20) & 0xFu; }
#define XB_SPIN(cond, bar) do { unsigned _sp = 0; while (cond) { __builtin_amdgcn_s_sleep(1); \
    if ((++_sp & 255u) == 0u) { if (xb_ld(&(bar)[XB_TMO])) break; if (_sp > XB_SPIN_CAP) { atomicAdd(&(bar)[XB_TMO], 1u); break; } } } } while (0)
struct XcdBarrier { unsigned* bar; unsigned x; volatile LAS unsigned* st; };
__device__ __forceinline__ XcdBarrier xcd_barrier_post(unsigned* bar, volatile LAS unsigned* st) {
    XcdBarrier b; b.bar = bar; b.x = xb_xcc_id(); b.st = st;
    if (threadIdx.x == 0) (void)xb_add(&bar[XB_XCNT(b.x)], 1u);
    return b;
}
__device__ __forceinline__ void xcd_barrier_complete(unsigned* bar, unsigned x, unsigned& nloc, unsigned& nx) {
    const unsigned G = gridDim.x * gridDim.y * gridDim.z;
    unsigned sum, cnt, mine, sp = 0u;
    for (;;) {
        sum = 0u; cnt = 0u; mine = 0u;
#pragma unroll
        for (unsigned j = 0; j < 16; ++j) { const unsigned c = xb_ld(&bar[XB_XCNT(j)]); sum += c; cnt += (c > 0u) ? 1u : 0u; mine = (j == x) ? c : mine; }
        if (sum == G) break;
        __builtin_amdgcn_s_sleep(1);
        if ((++sp & 255u) == 0u) { if (xb_ld(&bar[XB_TMO])) break; if (sp > XB_SPIN_CAP) { atomicAdd(&bar[XB_TMO], 1u); break; } }
    }
    nloc = mine > 0u ? mine : 1u; nx = cnt > 0u ? cnt : 1u;
}
__device__ __forceinline__ void xcd_barrier(const XcdBarrier& b) {
    asm volatile("s_waitcnt vmcnt(0)" ::: "memory");
    __syncthreads();
    if (threadIdx.x == 0) {
        unsigned* bar = b.bar;
        __builtin_amdgcn_s_waitcnt(0);
        unsigned nloc = b.st[0], nx = b.st[1];
        if (nloc == 0u) { xcd_barrier_complete(bar, b.x, nloc, nx); b.st[0] = nloc; b.st[1] = nx; }
        const unsigned old = xb_add(&bar[XB_XSUB(b.x)], 1u);
        const unsigned gen = old / nloc;
        if (old + 1u == (gen + 1u) * nloc) {
            __builtin_amdgcn_fence(__ATOMIC_RELEASE, "agent");
            asm volatile("s_waitcnt vmcnt(0)" ::: "memory");
            const unsigned og = xb_add(&bar[XB_TOP], 1u);
            const unsigned tg = og / nx;
            if (og + 1u == (tg + 1u) * nx) xb_add(&bar[XB_TOPGEN], 1u);
            else XB_SPIN(xb_ld(&bar[XB_TOPGEN]) == tg, bar);
            __builtin_amdgcn_fence(__ATOMIC_ACQUIRE, "agent");
            xb_add(&bar[XB_XGEN(b.x)], 1u);
            asm volatile("s_waitcnt vmcnt(0)" ::: "memory");
        } else {
            XB_SPIN(xb_ld(&bar[XB_XGEN(b.x)]) == gen, bar);
            __builtin_amdgcn_fence(__ATOMIC_ACQUIRE, "agent");
            asm volatile("s_waitcnt vmcnt(0)" ::: "memory");
        }
    }
    __syncthreads();
}

#define WT_JOBS(COND, WGT) \
_Pragma("unroll 1") \
        for (int job = 0; job < 31; ++job) { if (!(COND)) continue; \
            const float* src; int sld, K, Np, map; size_t doff; \
            if (job == 0)      { src = p.in[3];  sld = 5632; doff = O_W1IN;  K = 1024; Np = 5632; map = 1; } \
            else if (job == 1) { src = p.in[4];  sld = 1024; doff = O_W1DN;  K = 2816; Np = 1024; map = 0; } \
            else if (job == 2) { src = p.in[24]; sld = 5632; doff = O_W2IN;  K = 1024; Np = 5632; map = 1; } \
            else if (job == 3) { src = p.in[25]; sld = 1024; doff = O_W2DN;  K = 2816; Np = 1024; map = 0; } \
            else if (job == 4) { src = p.in[6];  sld = INW;  doff = O_WINA;  K = 1024; Np = 3840; map = 2; } \
            else if (job == 5) { src = p.in[6];  sld = INW;  doff = O_WGATE; K = 1024; Np = 3072; map = 3; } \
            else if (job == 6) { src = p.in[9];  sld = 1536; doff = O_WUQ;   K = 384;  Np = 1536; map = 0; } \
            else if (job == 7) { src = p.in[11]; sld = 2048; doff = O_WUK;   K = 256;  Np = 1024; map = 4; } \
            else if (job == 8) { src = p.in[11]; sld = 2048; doff = O_WUV;   K = 256;  Np = 1024; map = 5; } \
            else if (job == 9) { src = p.in[20]; sld = 2048; doff = O_WMK;   K = 1024; Np = 1024; map = 0; } \
            else if (job == 10) { src = p.in[20]; sld = 2048; doff = O_WMV;  K = 1024; Np = 1024; map = 6; } \
            else if (job < 14) { const int b = job - 11; src = p.in[21] + (size_t)b * D * D; sld = 1024; doff = O_WBR + (size_t)b * D * D * 2; K = 1024; Np = 1024; map = 0; } \
            else if (job == 14) { src = p.in[22]; sld = 1024; doff = O_WOUT; K = 1024; Np = 1024; map = 0; } \
            else if (job < 23) { const int n = job - 15; src = p.in[14] + n * 16384; sld = 128; doff = O_WRGA + (size_t)n * 32768; K = 128; Np = 128; map = 0; } \
            else { const int n = job - 23; src = p.in[16] + n * 16384; sld = 128; doff = O_WRGI + (size_t)n * 32768; K = 128; Np = 128; map = 0; } \
            wt_job<WGT>(src, sld, (bf16_t*)(ws + doff), K, Np, map, lds, G, c); \
        } \
        f32x2* rope = (f32x2*)(ws + O_ROPE); \

constexpr int N_PHASES = 20;
__global__ void __launch_bounds__(512, 2) mega(Params p) {
    extern __shared__ __attribute__((aligned(16))) unsigned char smem[];
    LAS unsigned char* lds = (LAS unsigned char*)smem;
    cg::grid_group grid = cg::this_grid();
    const int G = gridDim.x, c = blockIdx.x, tid = threadIdx.x;
    unsigned char* ws = p.ws;
#ifndef PH_MASK
#define PH_MASK 0xFFFFF
#endif
#ifndef REP_MASK
#define REP_MASK 0
#endif
#define REPS(k) for (int rep_ = 0; rep_ < (int)((REP_MASK >> (k)) & 1) + 1; ++rep_)
#define IN(k) (((PH_MASK >> (k)) & 1) && p.ph_lo <= (k) && (k) < p.ph_hi)
#define INM(j) (((PH_MASK >> (4 + (j))) & 1) && p.ph_lo <= (ph + (j)) && (ph + (j)) < p.ph_hi)
#define SEAM(k) do { if (p.ph_lo <= (k) && (k) + 1 < p.ph_hi) { xcd_barrier(xbar); } } while (0)
    bf16_t* Hb = (bf16_t*)(ws + O_H);
    if (tid < 4) ((LAS unsigned*)(lds + LDS_MAIN))[tid] = 0u;
    __syncthreads();
    XcdBarrier xbar = xcd_barrier_post((unsigned*)(ws + O_BAR), (volatile LAS unsigned*)(lds + LDS_MAIN));

    if (IN(0)) REPS(0) {
        WT_JOBS(job == 0 || job == 9 || job == 10, false);
        for (int i = c * 512 + tid; i < SEQ * 32; i += G * 512) { const int pos = i >> 5, fi = i & 31;
            const float inv = 1.0f / powf(10000.0f, (float)(2 * fi) / 64.0f); const float ang = (float)pos * inv; rope[i] = (f32x2){cosf(ang), sinf(ang)}; }
        rmsnorm_rows_bf16(p.in[1], p.in[19], (bf16_t*)(ws + O_MEMN), TMEM, G, c);
        rmsnorm_rows_bf16(p.in[0], p.in[2], Hb, T, G, c);
    }
    if (p.ph_lo < 0) grid.sync();
    SEAM(0);
    if (IN(1)) REPS(1) {
        pg8::Sched3 S{Hb, (const bf16_t*)(ws + O_W1IN), (const bf16_t*)(ws + O_MEMN), (const bf16_t*)(ws + O_WMK), (const bf16_t*)(ws + O_WMV), (const bf16_t*)(ws + O_MEMN),
                      T / 256, 22, TMEM / 256, 4, 4, TMEM / 256, G, c, 1024};
        pg8::EpiFfnIn E{(bf16_t*)(ws + O_HID), (bf16_t*)(ws + O_MEMK), (bf16_t*)(ws + O_MEMVT)};
        pg8::gemm_phase(lds, 1024, S, E);
        WT_JOBS(!(job == 0 || job == 9 || job == 10), true);
    }
    SEAM(1);
    if (IN(2)) REPS(2) {
        pg8::Sched3 S{(const bf16_t*)(ws + O_HID), (const bf16_t*)(ws + O_W1DN), nullptr, nullptr, nullptr, nullptr, T / 256, 4, 0, 0, 0, 0, G, c, FF};
        pg8::EpiResid E{p.in[0], p.out, 0.5f};
        pg8::gemm_phase(lds, FF, S, E);
    }
    SEAM(2);
    if (IN(3)) REPS(3) rmsnorm_rows_bf16(p.out, p.in[5], Hb, T, G, c);
    SEAM(3);
    bf16_t* zx = (bf16_t*)(ws + O_ZX); bf16_t* zg = (bf16_t*)(ws + O_ZG); bf16_t* zmq = (bf16_t*)(ws + O_ZMQ); bf16_t* zl = (bf16_t*)(ws + O_ZL);
    bf16_t* cqn = (bf16_t*)(ws + O_CQN); bf16_t* ckvn = (bf16_t*)(ws + O_CKVN); bf16_t* krope = (bf16_t*)(ws + O_KROPE);
    unsigned* lau = (unsigned*)(ws + O_LAU); f32x2* summ = (f32x2*)(ws + O_SUMM);
    bf16_t* qb = (bf16_t*)(ws + O_Q); bf16_t* knope = (bf16_t*)(ws + O_KNOPE); bf16_t* vt = (bf16_t*)(ws + O_VT);
    bf16_t* ya = (bf16_t*)(ws + O_LAU); bf16_t* yb = zx; bf16_t* yc = zmq;
    bf16_t* gtmp = zg; float* mrg = (float*)(ws + O_Q); bf16_t* merged = (bf16_t*)(ws + O_VT);
    const f32x2* rope = (const f32x2*)(ws + O_ROPE);
#pragma unroll 1
    for (int g = 0; g < NG; ++g) {
        const int ph = 4 + 6 * g;
        const bf16_t* h2g = Hb + (size_t)g * TG * D;
        if (INM(0)) REPS(4) {
            pg8::Sched3 S{h2g, (const bf16_t*)(ws + O_WINA), nullptr, nullptr, nullptr, nullptr, TG / 256, 15, 0, 0, 0, 0, G, c, 1024};
            pg8::EpiInProj E{zx, zg, zmq, zl};
            pg8::gemm_phase(lds, 1024, S, E);
        }
        SEAM(ph);
        if (INM(1)) REPS(5) {
            for (int it = c; it < GB * 16 * 8; it += G) { const int n = it & 7, tc = (it >> 3) & 15, gb = it >> 7; rglru_tile(lds, p, zx, lau, summ, gb, tc, n); }
            latent_rows(zl, p.in[8], p.in[10], rope, cqn, ckvn, krope, G, c);
        }
        SEAM(ph + 1);
        if (INM(2)) REPS(6) {
            { pg8::Sched3 S{cqn, (const bf16_t*)(ws + O_WUQ), nullptr, nullptr, nullptr, nullptr, TG / 256, 6, 0, 0, 0, 0, G, c, 384};
              pg8::EpiPlain1 E{qb, 1536, 0.07216878364870322f * 1.4426950408889634f}; pg8::gemm_phase(lds, 384, S, E); }
            { pg8::Sched3 S{ckvn, (const bf16_t*)(ws + O_WUK), nullptr, nullptr, nullptr, nullptr, TG / 256, 4, 0, 0, 0, 0, G, G - 1 - c, 256};
              pg8::EpiPlain1 E{knope, 1024, 1.0f}; pg8::gemm_phase(lds, 256, S, E); }
            const int Gv = (G == 256) ? 128 : G, cv = (G == 256) ? (c >= 128 ? c - 128 : (1 << 20)) : c;
            { pg8::Sched3 S{(const bf16_t*)(ws + O_WUV), ckvn, nullptr, nullptr, nullptr, nullptr, 4, TG / 256, 0, 0, 0, 0, Gv, cv, 256};
              pg8::EpiPlain1 E{vt, TG, 1.0f}; pg8::gemm_phase(lds, 256, S, E); }
            for (int it = c; it < GB * 16 * 2; it += G) { const int half = it & 1, tc = (it >> 1) & 15, gb = it >> 5; scan_apply(lau, summ, zg, yb, gb, tc, half); }
        }
        SEAM(ph + 2);
        if (INM(3)) {
#ifndef ATT_SEL
#define ATT_SEL 3
#endif
            if (ATT_SEL & 1) REPS(7) for (int pr0 = c; pr0 < GB * 8 * 4; pr0 += G) {
                const int pr = (G == 256) ? (((pr0 & 7) << 5) | (pr0 >> 3)) : pr0;
                const int qp = pr & 3, h = (pr >> 2) & 7, gb = pr >> 5;
#pragma unroll 1
                for (int w = 0; w < 2; ++w) { const int qblk = w == 0 ? 7 - qp : qp; const size_t tok0 = (size_t)gb * SEQ + qblk * 256;
                    attn_item<192, 128, 2, 128, true>(lds, qb + tok0 * 1536 + h * 192, 1536, knope + (size_t)gb * SEQ * 1024 + h * 128, 1024, krope + (size_t)gb * SEQ * 64, 64,
                        vt + (size_t)h * 128 * TG + (size_t)gb * SEQ, TG, ya + tok0 * 1024 + h * 128, 1024, 4 * qblk + 4, 4 * qblk + (tid >> 7) + 1,
                        0.07216878364870322f * 1.4426950408889634f, rope, qblk * 256); }
            }
            if (ATT_SEL & 2) for (int it = c; it < GB * 4 * 16; it += G) {
                const int qblk = it & 15, h = (it >> 4) & 3, gb = it >> 6; const int bglob = g * GB + gb; const size_t tok0 = (size_t)gb * SEQ + qblk * 128;
                attn_item<256, 256, 1, 256, false>(lds, zmq + tok0 * 1024 + h * 256, 1024, (const bf16_t*)(ws + O_MEMK) + (size_t)bglob * NMEM * 1024 + h * 256, 1024, nullptr, 0,
                    (const bf16_t*)(ws + O_MEMVT) + (size_t)h * 256 * TMEM + (size_t)bglob * NMEM, TMEM, yc + tok0 * 1024 + h * 256, 1024, 4, 4, 0.0625f * 1.4426950408889634f, rope, 0);
            }
        }
        SEAM(ph + 3);
        if (INM(4)) REPS(8) {
            pg8::SchedMerge S{ws, O_H + (size_t)g * TG * D * 2, G, c};
            pg8::EpiMerge E{gtmp, mrg, merged, p.in[7]};
            pg8::gemm_phase(lds, 1024, S, E);
        }
        SEAM(ph + 4);
        if (INM(5)) {
            pg8::Sched3 S{merged, (const bf16_t*)(ws + O_WOUT), nullptr, nullptr, nullptr, nullptr, TG / 256, 4, 0, 0, 0, 0, G, c, 1024};
            float* xo = p.out + (size_t)g * TG * D;
            pg8::EpiResid E{xo, xo, 1.0f};
            pg8::gemm_phase(lds, 1024, S, E);
        }
        if (g == NG - 1) SEAM(ph + 5);
    }
    if (IN(16)) REPS(16) rmsnorm_rows_bf16(p.out, p.in[23], Hb, T, G, c);
    SEAM(16);
    if (IN(17)) REPS(17) {
        pg8::Sched3 S{Hb, (const bf16_t*)(ws + O_W2IN), nullptr, nullptr, nullptr, nullptr, T / 256, 22, 0, 0, 0, 0, G, c, 1024};
        pg8::EpiFfnIn E{(bf16_t*)(ws + O_HID), nullptr, nullptr};
        pg8::gemm_phase(lds, 1024, S, E);
    }
    SEAM(17);
    if (IN(18)) {
        pg8::Sched3 S{(const bf16_t*)(ws + O_HID), (const bf16_t*)(ws + O_W2DN), nullptr, nullptr, nullptr, nullptr, T / 256, 4, 0, 0, 0, 0, G, c, FF};
        pg8::EpiResid E{p.out, p.out, 0.5f};
        pg8::gemm_phase(lds, FF, S, E);
    }
    SEAM(18);
    if (IN(19)) rmsnorm_rows_f32_inplace(p.out, p.in[26], T, G, c);
#undef IN
#undef INM
#undef SEAM
}

extern "C" void kernel_launch(void* const* d_in, const int* in_sizes, int n_in, void* d_out, int out_size, void* d_ws, size_t ws_size, hipStream_t stream) {
    static int grid = 0;
    if (grid == 0) {
        int dev = 0, cus = 0, per_cu = 0;
        hipGetDevice(&dev);
        hipDeviceGetAttribute(&cus, hipDeviceAttributeMultiprocessorCount, dev);
        hipFuncSetAttribute((const void*)mega, hipFuncAttributeMaxDynamicSharedMemorySize, LDS_BYTES);
        hipOccupancyMaxActiveBlocksPerMultiprocessor(&per_cu, (const void*)mega, 512, LDS_BYTES);
        if (per_cu < 1) { fprintf(stderr, "occupancy query returned %d\n", per_cu); per_cu = 1; }
        grid = cus * 1;
        if (ws_size < O_END) { fprintf(stderr, "workspace too small: %zu < %zu\n", ws_size, (size_t)O_END); grid = -1; }
    }
    if (grid < 0) return;
    Params p{};
    for (int i = 0; i < 27; ++i) p.in[i] = (const float*)d_in[i];
    p.out = (float*)d_out; p.ws = (unsigned char*)d_ws;
#if MK_ONE_LAUNCH
    p.ph_lo = 0; p.ph_hi = N_PHASES;
    (void)hipMemsetAsync((unsigned char*)d_ws + O_BAR, 0, XCD_BAR_WORDS * 4, stream);
    void* args[] = {&p};
    hipError_t e = hipLaunchCooperativeKernel((const void*)mega, dim3(grid), dim3(512), args, LDS_BYTES, stream);
    if (e != hipSuccess) fprintf(stderr, "cooperative launch failed: %s (grid %d)\n", hipGetErrorString(e), grid);
#else
    for (int k = 0; k < N_PHASES; ++k) { p.ph_lo = k; p.ph_hi = k + 1; hipLaunchKernelGGL(mega, dim3(grid), dim3(512), LDS_BYTES, stream, p); }
#endif
}
```
